# Optimizing an MI355X kernel written in HIP

```python
import math
import jax, jax.numpy as jnp
from jax import lax
import numpy as np

D_MODEL = 1024
BATCH = 32
SEQ = 2048
DEPTH = 1

CHUNK = 64
MIX_WIDTH = D_MODEL
RET_HEADS = 4
RET_VWIDTH = MIX_WIDTH // 2
RET_DV = RET_VWIDTH // RET_HEADS
RET_DK = RET_DV // 2
RET_QKWIDTH = RET_HEADS * RET_DK
POOL_WIDTH = MIX_WIDTH - RET_VWIDTH
POOL_WINDOWS = (2, 4, 8, 16)
POOL_GROUPS = len(POOL_WINDOWS)
POOL_GC = POOL_WIDTH // POOL_GROUPS
IN_WIDTH = 2 * RET_QKWIDTH + 2 * RET_VWIDTH + POOL_WIDTH
D_FF = 2816
ROPE_BASE = 10000.0
RMS_EPS = 1e-6
GN_EPS = 1e-5

kernel_name = "hybrid_retention_multiscale_pool_macaron"


def rms_norm(x, g):
    xf = x.astype(jnp.float32)
    y = xf * lax.rsqrt(jnp.mean(xf * xf, axis=-1, keepdims=True) + RMS_EPS)
    return (y * g.astype(jnp.float32)).astype(x.dtype)


def swiglu(x, w_gate, w_up, w_down):
    return (jax.nn.silu(x @ w_gate) * (x @ w_up)) @ w_down


def rotary(x, pos):
    d = x.shape[-1]
    half = d // 2
    freqs = ROPE_BASE ** (-jnp.arange(half, dtype=jnp.float32) * 2.0 / d)
    ang = pos.astype(jnp.float32)[:, None] * freqs[None, :]
    cos = jnp.cos(ang)[None, :, None, :].astype(x.dtype)
    sin = jnp.sin(ang)[None, :, None, :].astype(x.dtype)
    x1, x2 = x[..., :half], x[..., half:]
    return jnp.concatenate([x1 * cos - x2 * sin, x1 * sin + x2 * cos], axis=-1)


def retention_chunkwise(q, k, v):
    b, s, h, dk = q.shape
    dv = v.shape[-1]
    n = s // CHUNK
    dt = q.dtype
    gamma = 1.0 - 2.0 ** (-5.0 - jnp.arange(h, dtype=jnp.float32))
    log_g = jnp.log(gamma)
    idx = jnp.arange(CHUNK, dtype=jnp.float32)
    d_intra = jnp.exp(log_g[:, None, None] * jnp.abs(idx[:, None] - idx[None, :])).astype(dt)
    d_key = jnp.exp(log_g[:, None] * (CHUNK - 1.0 - idx)[None, :]).astype(dt)
    d_query = jnp.exp(log_g[:, None] * (idx + 1.0)[None, :]).astype(dt)
    d_chunk = jnp.exp(log_g * CHUNK).astype(dt)

    qc = (q * (dk ** -0.5)).reshape(b, n, CHUNK, h, dk)
    kc = k.reshape(b, n, CHUNK, h, dk)
    vc = v.reshape(b, n, CHUNK, h, dv)

    scores = jnp.einsum('bnihd,bnjhd->bnhij', qc, kc) * d_intra[None, None]
    intra = jnp.einsum('bnhij,bnjhe->bnihe', scores, vc)

    kv = jnp.einsum('bnjhd,hj,bnjhe->nbhde', kc, d_key, vc)

    def step(state, kv_n):
        return state * d_chunk[None, :, None, None] + kv_n, state

    init = jnp.zeros((b, h, dk, dv), dtype=kv.dtype)
    _, s_prev = lax.scan(step, init, kv)
    cross = jnp.einsum('bnihd,nbhde,hi->bnihe', qc, s_prev, d_query)
    return (intra + cross).reshape(b, s, h, dv)


def head_group_norm(o, gain):
    b, s, h, dv = o.shape
    of = o.astype(jnp.float32)
    mu = jnp.mean(of, axis=-1, keepdims=True)
    var = jnp.mean(jnp.square(of - mu), axis=-1, keepdims=True)
    y = ((of - mu) * lax.rsqrt(var + GN_EPS)).reshape(b, s, h * dv)
    return (y * gain.astype(jnp.float32)).astype(o.dtype)


def multiscale_pool(u, w_pool, scale):
    b, s, _ = u.shape
    ug = u.reshape(b, s, POOL_GROUPS, POOL_GC)
    cs = jnp.cumsum(ug.astype(jnp.float32), axis=1)
    cs = jnp.concatenate([jnp.zeros((b, 1, POOL_GROUPS, POOL_GC), jnp.float32), cs], axis=1)
    t = jnp.arange(s)
    win = jnp.array(POOL_WINDOWS, dtype=jnp.int32)
    lo = jnp.maximum(t[:, None] + 1 - win[None, :], 0)
    cnt = (t[:, None] + 1 - lo).astype(jnp.float32)
    cs_lo = cs[:, lo, jnp.arange(POOL_GROUPS)[None, :], :]
    mean = (cs[:, 1:] - cs_lo) / cnt[None, :, :, None]
    pooled = mean.astype(u.dtype) - ug
    y = jnp.einsum('bsgc,gcd->bsgd', pooled, w_pool).reshape(b, s, POOL_WIDTH)
    return y * scale


def hybrid_mixer(h, w_in, w_out, ret_gn_gain, pool_w, pool_scale):
    b, s, _ = h.shape
    p = h @ w_in
    o1 = RET_QKWIDTH
    o2 = o1 + RET_QKWIDTH
    o3 = o2 + RET_VWIDTH
    o4 = o3 + RET_VWIDTH
    q = p[..., :o1].reshape(b, s, RET_HEADS, RET_DK)
    k = p[..., o1:o2].reshape(b, s, RET_HEADS, RET_DK)
    v = p[..., o2:o3].reshape(b, s, RET_HEADS, RET_DV)
    g = p[..., o3:o4]
    u = p[..., o4:]
    pos = jnp.arange(s)
    q = rotary(q, pos)
    k = rotary(k, pos)
    ret = retention_chunkwise(q, k, v)
    ret = jax.nn.silu(g) * head_group_norm(ret, ret_gn_gain)
    pool = multiscale_pool(u, pool_w, pool_scale)
    return jnp.concatenate([ret, pool], axis=-1) @ w_out


def setup_inputs(seed: int = 0) -> dict:
    key = jax.random.key(seed)
    ks = jax.random.split(key, 20)
    f32 = jnp.float32
    nrm = lambda k_, shape, fan: jax.random.normal(k_, shape, f32) * (fan ** -0.5)
    gain = lambda k_, shape: 1.0 + 0.02 * jax.random.normal(k_, shape, f32)
    L = DEPTH
    return {
        "x": jax.random.normal(ks[0], (BATCH, SEQ, D_MODEL), f32),
        "norm_ffn1": gain(ks[1], (L, D_MODEL)),
        "ffn1_gate": nrm(ks[2], (L, D_MODEL, D_FF), D_MODEL),
        "ffn1_up": nrm(ks[3], (L, D_MODEL, D_FF), D_MODEL),
        "ffn1_down": nrm(ks[4], (L, D_FF, D_MODEL), D_FF),
        "norm_mix": gain(ks[5], (L, D_MODEL)),
        "w_in": nrm(ks[6], (L, D_MODEL, IN_WIDTH), D_MODEL),
        "ret_gn_gain": gain(ks[7], (L, RET_VWIDTH)),
        "pool_w": nrm(ks[8], (L, POOL_GROUPS, POOL_GC, POOL_GC), POOL_GC),
        "pool_scale": gain(ks[9], (L, POOL_WIDTH)),
        "w_out": nrm(ks[10], (L, MIX_WIDTH, D_MODEL), MIX_WIDTH),
        "norm_ffn2": gain(ks[11], (L, D_MODEL)),
        "ffn2_gate": nrm(ks[12], (L, D_MODEL, D_FF), D_MODEL),
        "ffn2_up": nrm(ks[13], (L, D_MODEL, D_FF), D_MODEL),
        "ffn2_down": nrm(ks[14], (L, D_FF, D_MODEL), D_FF),
        "norm_final": gain(ks[15], (D_MODEL,)),
    }


def reference(x, norm_ffn1, ffn1_gate, ffn1_up, ffn1_down, norm_mix, w_in,
              ret_gn_gain, pool_w, pool_scale, w_out, norm_ffn2, ffn2_gate,
              ffn2_up, ffn2_down, norm_final):
    for l in range(DEPTH):
        x = x + 0.5 * swiglu(rms_norm(x, norm_ffn1[l]), ffn1_gate[l], ffn1_up[l], ffn1_down[l])
        x = x + hybrid_mixer(rms_norm(x, norm_mix[l]), w_in[l], w_out[l],
                             ret_gn_gain[l], pool_w[l], pool_scale[l])
        x = x + 0.5 * swiglu(rms_norm(x, norm_ffn2[l]), ffn2_gate[l], ffn2_up[l], ffn2_down[l])
    return rms_norm(x, norm_final)
```

```cpp
#include <hip/hip_runtime.h>
#include <hip/hip_cooperative_groups.h>
#include <cstdio>
#include <cstdint>
namespace cg = cooperative_groups;
namespace pg8 {
#define PG8_LAS __attribute__((address_space(3)))
typedef unsigned short bf16_t;
typedef short bf16x8 __attribute__((ext_vector_type(8)));
typedef float f32x4 __attribute__((ext_vector_type(4)));
typedef unsigned u32x4 __attribute__((ext_vector_type(4)));
constexpr int BM = 256, BK = 64, HALF = 128, HTB = HALF * BK * 2  , STAGE_BYTES = 8 * HTB, NXCD = 8, WGM = 8;

__host__ __device__ __forceinline__ int lds_byte(int r, int c) { const int st = (r >> 4) * 2 + (c >> 5), rr = r & 15, cc = c & 31, ob = rr * 64 + cc * 2; return st * 1024 + (ob ^ (((ob >> 9) & 1) << 5)); }
__host__ __device__ __forceinline__ void stage_rc(int b, int& R, int& C) { const int st = b / 1024, sb = b % 1024, swz = sb ^ (((sb >> 9) & 1) << 5); R = (st >> 1) * 16 + swz / 64; C = (st & 1) * 32 + (swz % 64) / 2; }
__host__ __device__ __forceinline__ int perm32(int rho) { const int n = rho >> 4, i = rho & 15; return 8 * (i >> 2) + 4 * n + (i & 3); }

struct Unit { int pm, pn; };
struct Gemm { const bf16_t* A; const bf16_t* Bt; int M, N, K; };

struct StaticOrder {
    int nM, nN, nwg, G, c;
    __host__ __device__ void init(int M, int N, int G_, int c_) { nM = M / BM; nN = N / BM; nwg = nM * nN; G = G_; c = c_; }
    __host__ __device__ bool next(int i, Unit& u) const {
        const long L = (long)i * G + c; if (L >= nwg) return false;
        int wgid = (int)L; { const int q = nwg / NXCD, r = nwg % NXCD, xcd = wgid % NXCD, off = wgid / NXCD; wgid = (xcd < r ? xcd * (q + 1) : r * (q + 1) + (xcd - r) * q) + off; }
        const int nig = WGM * nN, gid = wgid / nig, fm = gid * WGM, gsz = (nM - fm) < WGM ? (nM - fm) : WGM;
        u.pm = fm + ((wgid % nig) % gsz); u.pn = (wgid % nig) / gsz; return true;
    }
    __device__ __forceinline__ void a_ready(const Unit&) const {}
    __device__ __forceinline__ void done(const Unit&) const {}
};

typedef __bf16 bf16v2 __attribute__((ext_vector_type(2)));
__device__ __forceinline__ unsigned cvt_pk_bf16(float lo, float hi) { typedef float f2 __attribute__((ext_vector_type(2))); const bf16v2 r = __builtin_convertvector((f2){lo, hi}, bf16v2); return __builtin_bit_cast(unsigned, r); }
typedef float f32x2 __attribute__((ext_vector_type(2)));
typedef unsigned u32x2 __attribute__((ext_vector_type(2)));
constexpr int DM = 1024, DFF = 2816;
constexpr float RMS_EPS = 1e-6f;
__device__ __forceinline__ float row_rstd(const float* ssq, int row, int fq) {
    const f32x4 p = *(const f32x4*)(ssq + (size_t)row * 16 + 4 * fq);
    float s = (p[0] + p[1]) + (p[2] + p[3]);
    s += __shfl_xor(s, 16); s += __shfl_xor(s, 32);
    return __builtin_amdgcn_rsqf(s * (1.0f / (float)DM) + RMS_EPS);
}
__device__ __forceinline__ float silu_f(float x) { return x * __builtin_amdgcn_rcpf(1.0f + __builtin_amdgcn_exp2f(-1.4426950408889634f * x)); }
__device__ __forceinline__ f32x4 silu4(f32x4 v) { return (f32x4){silu_f(v[0]), silu_f(v[1]), silu_f(v[2]), silu_f(v[3])}; }

__device__ __forceinline__ void rows_rstd(const float* ssq, int row0, int fq, float (&rs)[2][4]) {
    f32x4 p[2][4];
#pragma unroll
    for (int ai = 0; ai < 2; ++ai)
#pragma unroll
        for (int m = 0; m < 4; ++m) p[ai][m] = *(const f32x4*)(ssq + (size_t)(row0 + ai * HALF + m * 16) * 16 + 4 * fq);
#pragma unroll
    for (int ai = 0; ai < 2; ++ai)
#pragma unroll
        for (int m = 0; m < 4; ++m) { float s = (p[ai][m][0] + p[ai][m][1]) + (p[ai][m][2] + p[ai][m][3]); s += __shfl_xor(s, 16); s += __shfl_xor(s, 32); rs[ai][m] = __builtin_amdgcn_rsqf(s * (1.0f / (float)DM) + RMS_EPS); }
}
struct EpiSwiGLU {
    static constexpr bool PERM = true, AFTER_DRAIN = false;
    bf16_t* O; const float* ssq;
    __device__ __forceinline__ void operator()(const f32x4 (&acc)[2][2][4][2], const Unit& u, int wr, int wc, int fr, int fq) const {
        const int row0 = u.pm * BM + wr * 64 + fr, col0 = u.pn * HALF + wc * 32 + 8 * fq;
        float rsv[2][4]; rows_rstd(ssq, row0, fq, rsv);
#pragma unroll
        for (int ai = 0; ai < 2; ++ai)
#pragma unroll
            for (int m = 0; m < 4; ++m) {
                const int row = row0 + ai * HALF + m * 16; const float rs = rsv[ai][m];
                const f32x4 g0 = acc[ai][0][m][0] * rs, g1 = acc[ai][0][m][1] * rs, u0 = acc[ai][1][m][0] * rs, u1 = acc[ai][1][m][1] * rs;
                const f32x4 a0 = silu4(g0) * u0, a1 = silu4(g1) * u1;
                u32x4 w; w.x = cvt_pk_bf16(a0[0], a0[1]); w.y = cvt_pk_bf16(a0[2], a0[3]); w.z = cvt_pk_bf16(a1[0], a1[1]); w.w = cvt_pk_bf16(a1[2], a1[3]);
                *(u32x4*)(O + (((size_t)(row >> 8) * (DFF / BK) + (col0 >> 6)) * BM + (row & 255)) * BK + (col0 & 63)) = w;
            }
    }
};
__device__ __forceinline__ void bf8_to_f32(const u32x4 w, f32x4& lo, f32x4& hi) {
    lo = (f32x4){__builtin_bit_cast(float, w.x << 16), __builtin_bit_cast(float, w.x & 0xffff0000u), __builtin_bit_cast(float, w.y << 16), __builtin_bit_cast(float, w.y & 0xffff0000u)};
    hi = (f32x4){__builtin_bit_cast(float, w.z << 16), __builtin_bit_cast(float, w.z & 0xffff0000u), __builtin_bit_cast(float, w.w << 16), __builtin_bit_cast(float, w.w & 0xffff0000u)};
}
struct EpiResid {
    static constexpr bool PERM = true, AFTER_DRAIN = false;
    const bf16_t* base; bf16_t* xb; float* ssq; float alpha;
    __device__ __forceinline__ void operator()(const f32x4 (&acc)[2][2][4][2], const Unit& u, int wr, int wc, int fr, int fq) const {
        const int row0 = u.pm * BM + wr * 64 + fr, col0 = u.pn * BM + wc * 32 + 8 * fq;
#pragma unroll
        for (int ai = 0; ai < 2; ++ai) {
            u32x4 pre[4][2];
#pragma unroll
            for (int m = 0; m < 4; ++m)
#pragma unroll
                for (int bj = 0; bj < 2; ++bj) pre[m][bj] = *(const u32x4*)(base + (size_t)(row0 + ai * HALF + m * 16) * DM + col0 + bj * HALF);
#pragma unroll
            for (int m = 0; m < 4; ++m) {
                const int row = row0 + ai * HALF + m * 16; float q = 0.f;
#pragma unroll
                for (int bj = 0; bj < 2; ++bj) {
                    const size_t off = (size_t)row * DM + col0 + bj * HALF;
                    f32x4 b0, b1; bf8_to_f32(pre[m][bj], b0, b1);
                    const f32x4 o0 = b0 + acc[ai][bj][m][0] * alpha, o1 = b1 + acc[ai][bj][m][1] * alpha;
                    u32x4 w; w.x = cvt_pk_bf16(o0[0], o0[1]); w.y = cvt_pk_bf16(o0[2], o0[3]); w.z = cvt_pk_bf16(o1[0], o1[1]); w.w = cvt_pk_bf16(o1[2], o1[3]); *(u32x4*)(xb + off) = w;
                    q += (o0[0] * o0[0] + o0[1] * o0[1]) + (o0[2] * o0[2] + o0[3] * o0[3]) + (o1[0] * o1[0] + o1[1] * o1[1]) + (o1[2] * o1[2] + o1[3] * o1[3]);
                }
                q += __shfl_xor(q, 16); q += __shfl_xor(q, 32);
                if (fq == 0) ssq[(size_t)row * 16 + u.pn * 4 + wc] = q;
            }
        }
    }
};
struct EpiFinalNorm {
    static constexpr bool PERM = true, AFTER_DRAIN = false;
    const bf16_t* base; float* out; const float* gain; unsigned* xbuf; unsigned* cnt; PG8_LAS unsigned char* xl; float alpha;
    __device__ __forceinline__ void operator()(f32x4 (&acc)[2][2][4][2], const Unit& u, int wr, int wc, int fr, int fq) const {
        const int wid = wr * 4 + wc, lane = fq * 16 + fr;
        PG8_LAS float* Pt = (PG8_LAS float*)xl; PG8_LAS float* Sr = (PG8_LAS float*)(xl + 4096);
        const int row0 = u.pm * BM + wr * 64 + fr, col0 = u.pn * BM + wc * 32 + 8 * fq;
        f32x4 gv[2][2];
#pragma unroll
        for (int bj = 0; bj < 2; ++bj)
#pragma unroll
            for (int n = 0; n < 2; ++n) gv[bj][n] = *(const f32x4*)(gain + col0 + bj * HALF + 4 * n);
#pragma unroll
        for (int ai = 0; ai < 2; ++ai) {
            u32x4 pre[4][2];
#pragma unroll
            for (int m = 0; m < 4; ++m)
#pragma unroll
                for (int bj = 0; bj < 2; ++bj) pre[m][bj] = *(const u32x4*)(base + (size_t)(row0 + ai * HALF + m * 16) * DM + col0 + bj * HALF);
#pragma unroll
            for (int m = 0; m < 4; ++m) { float q = 0.f;
#pragma unroll
                for (int bj = 0; bj < 2; ++bj) {
                    f32x4 b0, b1; bf8_to_f32(pre[m][bj], b0, b1);
                    const f32x4 o0 = b0 + acc[ai][bj][m][0] * alpha, o1 = b1 + acc[ai][bj][m][1] * alpha;
                    acc[ai][bj][m][0] = o0; acc[ai][bj][m][1] = o1;
                    q += (o0[0] * o0[0] + o0[1] * o0[1]) + (o0[2] * o0[2] + o0[3] * o0[3]) + (o1[0] * o1[0] + o1[1] * o1[1]) + (o1[2] * o1[2] + o1[3] * o1[3]);
                }
                q += __shfl_xor(q, 16); q += __shfl_xor(q, 32);
                if (fq == 0) Pt[(ai * HALF + wr * 64 + m * 16 + fr) * 4 + wc] = q;
            }
        }
        asm volatile("s_waitcnt lgkmcnt(0)" ::: "memory"); __builtin_amdgcn_s_barrier(); asm volatile("" ::: "memory");
        const int row = wid * 32 + (lane & 31);
        if (lane < 32) { const f32x4 p = *(const PG8_LAS f32x4*)(Pt + row * 4);
            __hip_atomic_store(xbuf + (size_t)(u.pm * BM + row) * 4 + u.pn, __builtin_bit_cast(unsigned, (p[0] + p[1]) + (p[2] + p[3])), __ATOMIC_RELAXED, __HIP_MEMORY_SCOPE_AGENT); }
        asm volatile("s_waitcnt vmcnt(0)" ::: "memory");
        if (lane == 0) __hip_atomic_fetch_add(cnt + 64 * u.pm, 1u, __ATOMIC_RELAXED, __HIP_MEMORY_SCOPE_AGENT);
        if (wid == 0) {
            unsigned spins = 0u;
            while ((unsigned)__builtin_amdgcn_readfirstlane(__hip_atomic_load(cnt + 64 * u.pm, __ATOMIC_RELAXED, __HIP_MEMORY_SCOPE_AGENT)) < 32u) { __builtin_amdgcn_s_sleep(2); if (++spins > (1u << 22)) break; }
            __builtin_amdgcn_fence(__ATOMIC_ACQUIRE, "agent");
        }
        asm volatile("s_waitcnt vmcnt(0) lgkmcnt(0)" ::: "memory"); __builtin_amdgcn_s_barrier(); asm volatile("" ::: "memory");
        if (lane < 32) { const unsigned* slot = xbuf + (size_t)(u.pm * BM + row) * 4; float t = 0.f;
#pragma unroll
            for (int k = 0; k < 4; ++k) t += __builtin_bit_cast(float, __hip_atomic_load(slot + k, __ATOMIC_RELAXED, __HIP_MEMORY_SCOPE_AGENT));
            Sr[row] = __builtin_amdgcn_rsqf(t * (1.0f / (float)DM) + RMS_EPS); }
        asm volatile("s_waitcnt lgkmcnt(0)" ::: "memory"); __builtin_amdgcn_s_barrier(); asm volatile("" ::: "memory");
#pragma unroll
        for (int ai = 0; ai < 2; ++ai)
#pragma unroll
            for (int m = 0; m < 4; ++m) { const float rs = Sr[ai * HALF + wr * 64 + m * 16 + fr];
#pragma unroll
                for (int bj = 0; bj < 2; ++bj) { const size_t off = (size_t)(row0 + ai * HALF + m * 16) * DM + col0 + bj * HALF;
                    *(f32x4*)(out + off) = acc[ai][bj][m][0] * rs * gv[bj][0]; *(f32x4*)(out + off + 4) = acc[ai][bj][m][1] * rs * gv[bj][1]; } }
    }
};
struct EpiWin {
    static constexpr bool PERM = true, AFTER_DRAIN = false;
    bf16_t *Q, *V; const float* ssq; const float* ropec; const float* ropes;
    __device__ __forceinline__ void operator()(const f32x4 (&acc)[2][2][4][2], const Unit& u, int wr, int wc, int fr, int fq) const {
        const int row0 = u.pm * BM + wr * 64 + fr, pn = u.pn;
        float rsv[2][4]; rows_rstd(ssq, row0, fq, rsv);
        if (pn < 2) {
            const int i0 = 16 * (wc & 1) + 4 * fq; const float qs = pn == 0 ? 0.125f : 1.0f;
#pragma unroll
            for (int ai = 0; ai < 2; ++ai) {
                f32x4 cc[4], ss[4];
#pragma unroll
                for (int m = 0; m < 4; ++m) { const int pos = (row0 + ai * HALF + m * 16) & 2047; cc[m] = *(const f32x4*)(ropec + pos * 32 + i0); ss[m] = *(const f32x4*)(ropes + pos * 32 + i0); }
#pragma unroll
                for (int m = 0; m < 4; ++m) {
                    const int row = row0 + ai * HALF + m * 16; const float sc = qs * rsv[ai][m];
                    bf16_t* dst = Q + (size_t)pn * (16u << 20) + (size_t)row * 256;
#pragma unroll
                    for (int bj = 0; bj < 2; ++bj) {
                        const int head = 2 * bj + (wc >> 1);
                        const f32x4 x1 = acc[ai][bj][m][0] * sc, x2 = acc[ai][bj][m][1] * sc;
                        const f32x4 o1 = x1 * cc[m] - x2 * ss[m], o2 = x1 * ss[m] + x2 * cc[m];
                        u32x2 w1, w2; w1.x = cvt_pk_bf16(o1[0], o1[1]); w1.y = cvt_pk_bf16(o1[2], o1[3]); w2.x = cvt_pk_bf16(o2[0], o2[1]); w2.y = cvt_pk_bf16(o2[2], o2[3]);
                        *(u32x2*)(dst + head * 64 + i0) = w1; *(u32x2*)(dst + head * 64 + 32 + i0) = w2;
                    }
                }
            }
        } else {
            const bool act = (pn == 4 || pn == 5);
#pragma unroll
            for (int ai = 0; ai < 2; ++ai)
#pragma unroll
                for (int m = 0; m < 4; ++m) {
                    const int row = row0 + ai * HALF + m * 16; const float rs = rsv[ai][m];
                    bf16_t* dst = V + (size_t)((pn - 2) >> 1) * (32u << 20) + (size_t)row * 512 + (pn & 1) * 256 + wc * 32 + 8 * fq;
#pragma unroll
                    for (int bj = 0; bj < 2; ++bj) {
                        f32x4 v0 = acc[ai][bj][m][0] * rs, v1 = acc[ai][bj][m][1] * rs;
                        if (act) { v0 = silu4(v0); v1 = silu4(v1); }
                        u32x4 w; w.x = cvt_pk_bf16(v0[0], v0[1]); w.y = cvt_pk_bf16(v0[2], v0[3]); w.z = cvt_pk_bf16(v1[0], v1[1]); w.w = cvt_pk_bf16(v1[2], v1[3]);
                        *(u32x4*)(dst + bj * HALF) = w;
                    }
                }
        }
    }
};

template <class Epi, class Sched, bool ALIGN_EPI = false, bool SP2 = false, bool ATILED = false>
__device__ __forceinline__ void gemm_phase(PG8_LAS unsigned char* lds, const Gemm g, const Sched& S, const Epi& E) {
    const int tid = threadIdx.x, wid = __builtin_amdgcn_readfirstlane(tid >> 6), lane = tid & 63, wr = wid >> 2, wc = wid & 3, fr = lane & 15, fq = lane >> 4;
    const int K = g.K, nt = K / BK;
    unsigned voffA[2], voffB[2];
#pragma unroll
    for (int i = 0; i < 2; ++i) { int R, C; stage_rc(tid * 16 + i * 8192, R, C); const int Rb = Epi::PERM ? ((R & ~31) + perm32(R & 31)) : R;
        voffA[i] = (unsigned)(R * (ATILED ? BK : K) + C) * 2u; voffB[i] = (unsigned)(Rb * K + C) * 2u; }
    const size_t kstep = (size_t)(BK * 2);
    const size_t hstep = (size_t)HALF * K * 2;
    const size_t tstep = 2 * hstep;
    const size_t kstepA = ATILED ? (size_t)(BM * BK * 2) : kstep, hstepA = ATILED ? (size_t)(HALF * BK * 2) : hstep, tstepA = ATILED ? (size_t)nt * (BM * BK * 2) : tstep;
    const unsigned ldsw = (unsigned)wid * 1024u;
    const int aoff = lds_byte(wr * 64 + fr, fq * 8), boff = lds_byte(wc * 32 + fr, fq * 8);
#define PG8_SA(b, h) (((b) * 2 + (h)) * HTB)
#define PG8_SB(b, h) ((4 + (b) * 2 + (h)) * HTB)
#define PG8_STAGE(bufoff, gbase, voff) do { _Pragma("unroll") for (int _i = 0; _i < 2; ++_i) \
        __builtin_amdgcn_global_load_lds((const unsigned*)((const char*)(gbase) + (voff)[_i]), (PG8_LAS unsigned*)(lds + (bufoff) + ldsw + _i * 8192), 16, 0, 0); } while (0)
#define PG8_LDA(dst, b, h) do { _Pragma("unroll") for (int m = 0; m < 4; ++m) _Pragma("unroll") for (int k = 0; k < 2; ++k) dst[m][k] = *(const PG8_LAS bf16x8*)(lds + PG8_SA(b, h) + aoff + m * 2048 + k * 1024); } while (0)
#define PG8_LDB(dst, b, h) do { _Pragma("unroll") for (int n = 0; n < 2; ++n) _Pragma("unroll") for (int k = 0; k < 2; ++k) dst[n][k] = *(const PG8_LAS bf16x8*)(lds + PG8_SB(b, h) + boff + n * 2048 + k * 1024); } while (0)
#define PG8_MMA(ai, bj, At, Bt) do { __builtin_amdgcn_s_setprio(1); _Pragma("unroll") for (int m = 0; m < 4; ++m) _Pragma("unroll") for (int n = 0; n < 2; ++n) _Pragma("unroll") for (int k = 0; k < 2; ++k) \
        acc[ai][bj][m][n] = __builtin_amdgcn_mfma_f32_16x16x32_bf16(Bt[n][k], At[m][k], acc[ai][bj][m][n], 0, 0, 0); __builtin_amdgcn_s_setprio(0); } while (0)
#define PG8_WAIT_V(n) asm volatile("s_waitcnt vmcnt(" #n ")" ::: "memory")
#define PG8_WAIT_L(n) asm volatile("s_waitcnt lgkmcnt(" #n ")" ::: "memory")
#define PG8_BAR __builtin_amdgcn_s_barrier()
#define PG8_SCHED __builtin_amdgcn_sched_barrier(0)
    Unit cur, nxt; int ui = 0;
    if (!S.next(0, cur)) return;
    f32x4 acc[2][2][4][2];
#pragma unroll
    for (int a = 0; a < 2; ++a)
#pragma unroll
        for (int b = 0; b < 2; ++b)
#pragma unroll
            for (int m = 0; m < 4; ++m)
#pragma unroll
                for (int n = 0; n < 2; ++n) acc[a][b][m][n] = (f32x4){0.f, 0.f, 0.f, 0.f};
    bf16x8 At[4][2], B0[2][2], B1[2][2];
    const char* cA = (const char*)g.A + (size_t)cur.pm * tstepA; const char* cB = (const char*)g.Bt + (size_t)cur.pn * tstep;
    S.a_ready(cur);
    if constexpr (SP2) {
        PG8_STAGE(PG8_SB(0, 0), cB, voffB); PG8_STAGE(PG8_SB(0, 1), cB + hstep, voffB); PG8_STAGE(PG8_SA(0, 0), cA, voffA); PG8_STAGE(PG8_SA(0, 1), cA + hstepA, voffA);
        if (wr == 1) PG8_BAR;
        PG8_WAIT_V(2); PG8_BAR;
        PG8_STAGE(PG8_SB(1, 0), cB + kstep, voffB); PG8_STAGE(PG8_SA(1, 0), cA + kstepA, voffA); PG8_STAGE(PG8_SB(1, 1), cB + hstep + kstep, voffB);
        PG8_WAIT_V(6); PG8_BAR;
    } else {
        PG8_STAGE(PG8_SB(0, 0), cB, voffB); PG8_STAGE(PG8_SA(0, 0), cA, voffA); PG8_STAGE(PG8_SB(0, 1), cB + hstep, voffB); PG8_STAGE(PG8_SA(0, 1), cA + hstepA, voffA);
        if (wr == 1) PG8_BAR;
        PG8_WAIT_V(4); PG8_BAR;
        PG8_STAGE(PG8_SB(1, 0), cB + kstep, voffB); PG8_STAGE(PG8_SA(1, 0), cA + kstepA, voffA); PG8_STAGE(PG8_SB(1, 1), cB + hstep + kstep, voffB);
        PG8_WAIT_V(6); PG8_BAR;
    }
    for (;;) {
        const bool has_next = S.next(ui + 1, nxt);
        const char* nA = has_next ? (const char*)g.A + (size_t)nxt.pm * tstepA : cA; const char* nB = has_next ? (const char*)g.Bt + (size_t)nxt.pn * tstep : cB;
        for (int t = 0; t < nt; t += 2) {
            const bool last = (t == nt - 2);
            const char* a1 = cA + (size_t)(t + 1) * kstepA;
            const char* a2 = last ? nA : cA + (size_t)(t + 2) * kstepA; const char* b2 = last ? nB : cB + (size_t)(t + 2) * kstep;
            const char* a3 = a2 + kstepA; const char* b3 = b2 + kstep;
            if (last && has_next) S.a_ready(nxt);
            if constexpr (SP2) {
            PG8_LDB(B0, 0, 0); PG8_LDB(B1, 0, 1); PG8_SCHED; PG8_LDA(At, 0, 0); PG8_STAGE(PG8_SA(1, 1), a1 + hstepA, voffA);
            PG8_WAIT_V(8); PG8_WAIT_L(0); PG8_BAR; PG8_MMA(0, 0, At, B0); PG8_MMA(0, 1, At, B1); PG8_BAR; PG8_SCHED;
            PG8_LDA(At, 0, 1); PG8_STAGE(PG8_SB(0, 0), b2, voffB); PG8_STAGE(PG8_SB(0, 1), b2 + hstep, voffB); PG8_STAGE(PG8_SA(0, 0), a2, voffA);
            PG8_WAIT_V(8); PG8_WAIT_L(0); PG8_BAR; PG8_MMA(1, 0, At, B0); PG8_MMA(1, 1, At, B1); PG8_BAR; PG8_SCHED;
            PG8_LDB(B0, 1, 0); PG8_LDB(B1, 1, 1); PG8_SCHED; PG8_LDA(At, 1, 0); PG8_STAGE(PG8_SA(0, 1), a2 + hstepA, voffA);
            PG8_WAIT_V(8); PG8_WAIT_L(0); PG8_BAR; PG8_MMA(0, 0, At, B0); PG8_MMA(0, 1, At, B1); PG8_BAR; PG8_SCHED;
            PG8_LDA(At, 1, 1); PG8_STAGE(PG8_SB(1, 0), b3, voffB); PG8_STAGE(PG8_SB(1, 1), b3 + hstep, voffB); PG8_STAGE(PG8_SA(1, 0), a3, voffA);
            PG8_WAIT_V(8); PG8_WAIT_L(0); PG8_BAR; PG8_MMA(1, 0, At, B0); PG8_MMA(1, 1, At, B1); PG8_BAR; PG8_SCHED;
            } else {
            PG8_LDB(B0, 0, 0); PG8_SCHED; PG8_LDA(At, 0, 0); PG8_STAGE(PG8_SA(1, 1), a1 + hstepA, voffA);
            PG8_WAIT_L(8); PG8_BAR; PG8_WAIT_L(0); PG8_MMA(0, 0, At, B0); PG8_BAR; PG8_SCHED;
            PG8_LDB(B1, 0, 1); PG8_STAGE(PG8_SB(0, 0), b2, voffB);
            PG8_BAR; PG8_WAIT_L(0); PG8_MMA(0, 1, At, B1); PG8_BAR;
            PG8_LDA(At, 0, 1); PG8_STAGE(PG8_SA(0, 0), a2, voffA);
            PG8_BAR; PG8_WAIT_L(0); PG8_MMA(1, 0, At, B0); PG8_BAR; PG8_SCHED;
            PG8_STAGE(PG8_SB(0, 1), b2 + hstep, voffB);
            PG8_WAIT_V(6); PG8_BAR; PG8_MMA(1, 1, At, B1); PG8_BAR;
            PG8_LDB(B0, 1, 0); PG8_SCHED; PG8_LDA(At, 1, 0); PG8_STAGE(PG8_SA(0, 1), a2 + hstepA, voffA);
            PG8_WAIT_L(8); PG8_BAR; PG8_WAIT_L(0); PG8_MMA(0, 0, At, B0); PG8_BAR; PG8_SCHED;
            PG8_LDB(B1, 1, 1); PG8_STAGE(PG8_SB(1, 0), b3, voffB);
            PG8_BAR; PG8_WAIT_L(0); PG8_MMA(0, 1, At, B1); PG8_BAR;
            PG8_LDA(At, 1, 1); PG8_STAGE(PG8_SA(1, 0), a3, voffA);
            PG8_BAR; PG8_WAIT_L(0); PG8_MMA(1, 0, At, B0); PG8_BAR; PG8_SCHED;
            PG8_STAGE(PG8_SB(1, 1), b3 + hstep, voffB);
            PG8_WAIT_V(6); PG8_BAR; PG8_MMA(1, 1, At, B1); PG8_BAR;
            }
        }
        if constexpr (ALIGN_EPI) { if (wr == 0) PG8_BAR; }
        if constexpr (!Epi::AFTER_DRAIN) { E(acc, cur, wr, wc, fr, fq); S.done(cur); }
        if (!has_next) break;
#pragma unroll
        for (int a = 0; a < 2; ++a)
#pragma unroll
            for (int b = 0; b < 2; ++b)
#pragma unroll
                for (int m = 0; m < 4; ++m)
#pragma unroll
                    for (int n = 0; n < 2; ++n) acc[a][b][m][n] = (f32x4){0.f, 0.f, 0.f, 0.f};
        cur = nxt; cA = nA; cB = nB; ++ui;
        if constexpr (ALIGN_EPI) { if (wr == 1) PG8_BAR; }
    }
    PG8_WAIT_V(0);
    if constexpr (!ALIGN_EPI) { if (wr == 0) PG8_BAR; }
    PG8_BAR;
    if constexpr (Epi::AFTER_DRAIN) { E.fused(acc, cur, wr, wc, fr, fq, lds, wid, lane); S.done(cur); }
#undef PG8_SA
#undef PG8_SB
#undef PG8_STAGE
#undef PG8_LDA
#undef PG8_LDB
#undef PG8_MMA
#undef PG8_WAIT_V
#undef PG8_WAIT_L
#undef PG8_BAR
#undef PG8_SCHED
}
}

constexpr int NWAVES = 8, NTHREADS = 512;
constexpr int BATCH = 32, SEQ = 2048, D = 1024, FF = 2816, NGU = 2 * FF, INW = 2048, M = BATCH * SEQ;
constexpr int NPHASE = 8;
#define MK_SANITIZE 0
#ifndef MK_REPEAT_MASK
#define MK_REPEAT_MASK 0
#endif
#define REP(k) for (int rep_ = 0; rep_ <= ((MK_REPEAT_MASK >> (k)) & 1); ++rep_)
#define MK_SKIP_MASK 0
#define MK_NO_RET 0
#define MK_NO_POOL 0
#define MK_POOL_FROM_XB 0
#ifndef MK_N_LAUNCHES
#define MK_N_LAUNCHES 1
#endif
constexpr size_t MiB = 1u << 20;
constexpr size_t WS_XB = 0;
constexpr size_t WS_BIG = 128 * MiB;
constexpr size_t WS_Q = WS_BIG, WS_K = WS_Q + 32 * MiB, WS_V = WS_K + 32 * MiB, WS_SG = WS_V + 64 * MiB, WS_U = WS_SG + 64 * MiB, WS_RS = WS_U + 64 * MiB;
constexpr size_t WS_W = 512 * MiB;
constexpr size_t WS_WGU1 = WS_W, WS_WD1 = WS_WGU1 + (size_t)NGU * D * 2, WS_WGU2 = WS_WD1 + (size_t)D * FF * 2, WS_WD2 = WS_WGU2 + (size_t)NGU * D * 2;
constexpr size_t WS_WIN = WS_WD2 + (size_t)D * FF * 2, WS_WOUT = WS_WIN + (size_t)INW * D * 2, WS_WP = WS_WOUT + (size_t)D * D * 2;
constexpr size_t WS_SSQ = 576 * MiB;
constexpr size_t WS_ROPEC = 584 * MiB, WS_ROPES = WS_ROPEC + 2048 * 32 * 4;
constexpr size_t WS_CTL = 592 * MiB, CTL_BYTES = 131072, CTL_CNT = 65536;
constexpr size_t WS_XBUF = 593 * MiB;
constexpr size_t WS_END = 595 * MiB;
static_assert(WS_K == WS_Q + 32 * MiB && WS_SG == WS_V + 64 * MiB && WS_U == WS_V + 128 * MiB, "EpiWin pointer arithmetic");
static_assert(WS_RS + (size_t)M * D * 2 <= WS_W && WS_BIG + (size_t)M * FF * 2 <= WS_W && WS_WP + 4 * 128 * 128 * 2 <= WS_SSQ, "d_ws map");
constexpr int LDS_BYTES = 147456, LDS_BARST = 147456 - 64;

#define LAS __attribute__((address_space(3)))
typedef unsigned short bf16;
typedef unsigned v4u __attribute__((ext_vector_type(4)));
typedef unsigned v2u __attribute__((ext_vector_type(2)));
typedef float f32x4 __attribute__((ext_vector_type(4)));
typedef short bf16x8 __attribute__((ext_vector_type(8)));
#define LBAR() do { asm volatile("s_waitcnt lgkmcnt(0)" ::: "memory"); __builtin_amdgcn_s_barrier(); asm volatile("" ::: "memory"); } while (0)
__device__ __forceinline__ unsigned f2bf(float f) { return (unsigned)__builtin_bit_cast(unsigned short, (__bf16)f); }
__device__ __forceinline__ unsigned pk2(float lo, float hi) { return pg8::cvt_pk_bf16(lo, hi); }
__device__ __forceinline__ float bflo(unsigned w) { return __builtin_bit_cast(float, w << 16); }
__device__ __forceinline__ float bfhi(unsigned w) { return __builtin_bit_cast(float, w & 0xffff0000u); }
__device__ __forceinline__ float bf2f(unsigned short h) { return __builtin_bit_cast(float, (unsigned)h << 16); }
__device__ __forceinline__ float wave_sum(float v) {
#pragma unroll
    for (int o = 1; o < 64; o <<= 1) v += __shfl_xor(v, o);
    return v;
}
__device__ __forceinline__ f32x4 mfma16(bf16x8 a, bf16x8 b, f32x4 c) { return __builtin_amdgcn_mfma_f32_16x16x32_bf16(a, b, c, 0, 0, 0); }

__device__ const float ROPE_FREQ[32] = {
    1.000000000e+00f, 7.498942614e-01f, 5.623413324e-01f, 4.216965139e-01f, 3.162277639e-01f, 2.371373773e-01f, 1.778279394e-01f, 1.333521307e-01f,
    1.000000015e-01f, 7.498941571e-02f, 5.623413250e-02f, 4.216965288e-02f, 3.162277490e-02f, 2.371373773e-02f, 1.778279431e-02f, 1.333521493e-02f,
    9.999999776e-03f, 7.498941850e-03f, 5.623413250e-03f, 4.216964822e-03f, 3.162277630e-03f, 2.371373586e-03f, 1.778279431e-03f, 1.333521446e-03f,
    1.000000047e-03f, 7.498942432e-04f, 5.623413017e-04f, 4.216965172e-04f, 3.162277571e-04f, 2.371373703e-04f, 1.778279402e-04f, 1.333521504e-04f};

#define RLX_AGENT __ATOMIC_RELAXED, __HIP_MEMORY_SCOPE_AGENT
#define XB_TMO      128
#define XB_XCNT(j)  (256  + 64 * (j))
#define XB_XSUB(j)  (1280 + 64 * (j))
#define XB_XGEN(j)  (2304 + 64 * (j))
#define XB_TOP      3328
#define XB_TOPGEN   3392
#define XCD_BAR_WORDS 3456
#define XB_SPIN_CAP (1u << 18)

__device__ __forceinline__ unsigned xb_ld(unsigned* p)              { return __hip_atomic_load(p, __ATOMIC_RELAXED, __HIP_MEMORY_SCOPE_AGENT); }
__device__ __forceinline__ unsigned xb_add(unsigned* p, unsigned v) { return __hip_atomic_fetch_add(p, v, __ATOMIC_RELAXED, __HIP_MEMORY_SCOPE_AGENT); }
__device__ __forceinline__ unsigned xb_xcc_id() { return (unsigned)__builtin_amdgcn_s_getreg((3 << 11) | 20) & 0xFu; }
#define XB_SPIN(cond, bar) do { unsigned _sp = 0; while (cond) { __builtin_amdgcn_s_sleep(1); \
    if ((++_sp & 255u) == 0u) { if (xb_ld(&(bar)[XB_TMO])) break; if (_sp > XB_SPIN_CAP) { atomicAdd(&(bar)[XB_TMO], 1u); break; } } } } while (0)

struct XcdBarrier {
    unsigned* bar; unsigned x;
    volatile LAS unsigned* st;
};

__device__ __forceinline__ XcdBarrier xcd_barrier_post(unsigned* bar, volatile LAS unsigned* st) {
    XcdBarrier b; b.bar = bar; b.x = xb_xcc_id(); b.st = st;
    if (threadIdx.x == 0) (void)xb_add(&bar[XB_XCNT(b.x)], 1u);
    return b;
}
__device__ __forceinline__ void xcd_barrier_complete(unsigned* bar, unsigned x, unsigned& nloc, unsigned& nx) {
    const unsigned G = gridDim.x * gridDim.y * gridDim.z;
    unsigned sum, cnt, mine, sp = 0u;
    for (;;) {
        sum = 0u; cnt = 0u; mine = 0u;
#pragma unroll
        for (unsigned j = 0; j < 16; ++j) { const unsigned c = xb_ld(&bar[XB_XCNT(j)]); sum += c; cnt += (c > 0u) ? 1u : 0u; mine = (j == x) ? c : mine; }
        if (sum == G) break;
        __builtin_amdgcn_s_sleep(1);
        if ((++sp & 255u) == 0u) { if (xb_ld(&bar[XB_TMO])) break; if (sp > XB_SPIN_CAP) { atomicAdd(&bar[XB_TMO], 1u); break; } }
    }
    nloc = mine > 0u ? mine : 1u; nx = cnt > 0u ? cnt : 1u;
}

__device__ __forceinline__ void xcd_barrier(const XcdBarrier& b) {
    asm volatile("s_waitcnt vmcnt(0)" ::: "memory");
    __syncthreads();
    if (threadIdx.x == 0) {
        unsigned* bar = b.bar;
        __builtin_amdgcn_s_waitcnt(0);
        unsigned nloc = b.st[0], nx = b.st[1];
        if (nloc == 0u) { xcd_barrier_complete(bar, b.x, nloc, nx); b.st[0] = nloc; b.st[1] = nx; }
        const unsigned old = xb_add(&bar[XB_XSUB(b.x)], 1u);
        const unsigned gen = old / nloc;
        if (old + 1u == (gen + 1u) * nloc) {
            __builtin_amdgcn_fence(__ATOMIC_RELEASE, "agent");
            asm volatile("s_waitcnt vmcnt(0)" ::: "memory");
            const unsigned og = xb_add(&bar[XB_TOP], 1u);
            const unsigned tg = og / nx;
            if (og + 1u == (tg + 1u) * nx) xb_add(&bar[XB_TOPGEN], 1u);
            else XB_SPIN(xb_ld(&bar[XB_TOPGEN]) == tg, bar);
            __builtin_amdgcn_fence(__ATOMIC_ACQUIRE, "agent");
            xb_add(&bar[XB_XGEN(b.x)], 1u);
            asm volatile("s_waitcnt vmcnt(0)" ::: "memory");
        } else {
            XB_SPIN(xb_ld(&bar[XB_XGEN(b.x)]) == gen, bar);
            __builtin_amdgcn_fence(__ATOMIC_ACQUIRE, "agent");
            asm volatile("s_waitcnt vmcnt(0)" ::: "memory");
        }
    }
    __syncthreads();
}

__device__ __forceinline__ int wrow(int kind, int n) {
    if (kind == 0) return n;
    if (kind == 1) return 256 * (n >> 7) + (n & 127);
    if (kind == 2) return 256 * (n >> 7) + 128 + (n & 127);
    if (n >= 512) return n;
    const int base = n & ~255, o = n & 255, head = o >> 6, r = o & 63, nn = r >> 5, i = r & 31;
    const int bj = head >> 1, wc = 2 * (head & 1) + (i >> 4), fq = (i & 15) >> 2, e = i & 3;
    return base + 128 * bj + 32 * wc + 8 * fq + 4 * nn + e;
}
__device__ __forceinline__ void p0_transpose_item(const float* W, int K, int N, bf16* WT, int kind, const float* gain, LAS float* scr, int item, int lane) {
    const int nblk = N / 32, kb = item / nblk, nb = item % nblk, k0 = 64 * kb, n0 = 32 * nb;
    float wv[32];
#pragma unroll
    for (int i = 0; i < 32; ++i) wv[i] = W[(size_t)(k0 + 2 * i + (lane >> 5)) * N + n0 + (lane & 31)];
    if (gain) {
#pragma unroll
        for (int i = 0; i < 32; ++i) wv[i] *= gain[k0 + 2 * i + (lane >> 5)];
    }
#pragma unroll
    for (int i = 0; i < 32; ++i) scr[(2 * i + (lane >> 5)) * 33 + (lane & 31)] = wv[i];
    asm volatile("s_waitcnt lgkmcnt(0)" ::: "memory");
    const int c = lane & 7;
#pragma unroll
    for (int j = 0; j < 4; ++j) { const int n = (lane >> 3) + 8 * j; const LAS float* s = scr + (8 * c) * 33 + n;
        v4u o; o.x = pk2(s[0 * 33], s[1 * 33]); o.y = pk2(s[2 * 33], s[3 * 33]); o.z = pk2(s[4 * 33], s[5 * 33]); o.w = pk2(s[6 * 33], s[7 * 33]);
        *(v4u*)(WT + (size_t)wrow(kind, n0 + n) * K + k0 + 8 * c) = o; }
    asm volatile("s_waitcnt lgkmcnt(0)" ::: "memory");
}

struct Ptrs {
    const float *x, *n1, *g1, *u1, *d1, *nm, *win, *gng, *pw, *ps, *wout, *n2, *g2, *u2, *d2, *nf;
    float* out;
    bf16 *XB, *ACT, *Q, *K, *V, *SG, *U, *RS, *WGU1, *WD1, *WGU2, *WD2, *WIN, *WOUT, *WP;
    float *SSQ, *ROPEC, *ROPES;
};

__device__ __forceinline__ void p0_prologue(const Ptrs& P, LAS unsigned char* lds, int tid, int lane, int wave) {
    LAS float* scr = (LAS float*)(lds + wave * 16384);
    const int gw = blockIdx.x * NWAVES + wave, NGW = gridDim.x * NWAVES;
    constexpr int I_GU = (D / 64) * (FF / 32), I_DN = (FF / 64) * (D / 32), I_IN = (D / 64) * (INW / 32), I_OUT = (D / 64) * (D / 32);
    constexpr int NITEMS = 4 * I_GU + 2 * I_DN + I_IN + I_OUT;
    for (int it = gw; it < NITEMS; it += NGW) {
        int r = it;
        if (r < I_GU) { p0_transpose_item(P.g1, D, FF, P.WGU1, 1, P.n1, scr, r, lane); continue; } r -= I_GU;
        if (r < I_GU) { p0_transpose_item(P.u1, D, FF, P.WGU1, 2, P.n1, scr, r, lane); continue; } r -= I_GU;
        if (r < I_DN) { p0_transpose_item(P.d1, FF, D, P.WD1, 0, nullptr, scr, r, lane); continue; } r -= I_DN;
        if (r < I_GU) { p0_transpose_item(P.g2, D, FF, P.WGU2, 1, P.n2, scr, r, lane); continue; } r -= I_GU;
        if (r < I_GU) { p0_transpose_item(P.u2, D, FF, P.WGU2, 2, P.n2, scr, r, lane); continue; } r -= I_GU;
        if (r < I_DN) { p0_transpose_item(P.d2, FF, D, P.WD2, 0, nullptr, scr, r, lane); continue; } r -= I_DN;
        if (r < I_IN) { p0_transpose_item(P.win, D, INW, P.WIN, 3, P.nm, scr, r, lane); continue; } r -= I_IN;
        p0_transpose_item(P.wout, D, D, P.WOUT, 0, nullptr, scr, r, lane);
    }
    const int gt = blockIdx.x * NTHREADS + tid, NGT = gridDim.x * NTHREADS;
    for (int i = gt; i < 4 * 128 * 128; i += NGT) { const int g = i >> 14, d = (i >> 7) & 127, c = i & 127; P.WP[i] = (bf16)f2bf(P.pw[(g * 128 + c) * 128 + d] * P.ps[g * 128 + d]); }
    for (int i = gt; i < 2048 * 32; i += NGT) { const int pos = i >> 5; const float ang = (float)pos * ROPE_FREQ[i & 31];
        double rev = (double)ang * 0.15915494309189535; rev -= __builtin_floor(rev); const float rf = (float)rev;
        P.ROPEC[i] = __builtin_amdgcn_cosf(rf); P.ROPES[i] = __builtin_amdgcn_sinf(rf); }
    for (int m = 2 * gw; m < M; m += 2 * NGW) {
        const f32x4* xr = (const f32x4*)(P.x + (size_t)m * D) + lane; f32x4 v[2][4]; float s[2] = {0.f, 0.f};
#pragma unroll
        for (int r = 0; r < 2; ++r)
#pragma unroll
            for (int j = 0; j < 4; ++j) v[r][j] = xr[r * (D / 4) + 64 * j];
#pragma unroll
        for (int r = 0; r < 2; ++r) {
#pragma unroll
            for (int j = 0; j < 4; ++j) s[r] += (v[r][j][0] * v[r][j][0] + v[r][j][1] * v[r][j][1]) + (v[r][j][2] * v[r][j][2] + v[r][j][3] * v[r][j][3]);
            s[r] = wave_sum(s[r]);
            v2u* o8 = (v2u*)(P.XB + (size_t)(m + r) * D) + lane;
#pragma unroll
            for (int j = 0; j < 4; ++j) { v2u w; w.x = pk2(v[r][j][0], v[r][j][1]); w.y = pk2(v[r][j][2], v[r][j][3]); o8[64 * j] = w; }
            if (lane < 16) P.SSQ[(size_t)(m + r) * 16 + lane] = lane == 0 ? s[r] : 0.f;
        }
    }
}

namespace mix {
constexpr int S72 = 72, S136 = 136, S144 = 144;
constexpr int OFF_Q = 0, OFF_K = 9216, OFF_K2 = 18432, OFF_V = 27648, OFF_S = 46080, OFF_ST = 55296, OFF_SG = 73728, OFF_O = 91136, OFF_PART = 108544, OFF_STAT = 124928;
__device__ const float LG2[4] = {-0.04580368961312479f, -0.02272007650008353f, -0.011315313227834146f, -0.005646563141142063f};
__device__ __forceinline__ float ex2(float x) { return __builtin_amdgcn_exp2f(x); }
typedef short s16x4 __attribute__((ext_vector_type(4)));
__device__ __forceinline__ bf16x8 tr_frag(LAS unsigned char* img, int pitch, int c, int ks, int fq, int fr) {
    LAS unsigned char* a0 = img + (32 * ks + 8 * fq + (fr >> 2)) * pitch + 32 * c + 8 * (fr & 3);
    const s16x4 lo = __builtin_amdgcn_ds_read_tr16_b64_v4i16((LAS s16x4*)a0), hi = __builtin_amdgcn_ds_read_tr16_b64_v4i16((LAS s16x4*)(a0 + 4 * pitch));
    return __builtin_shufflevector(lo, hi, 0, 1, 2, 3, 4, 5, 6, 7);
}

constexpr int RSET = 46080, ROFF_Q = 0, ROFF_K = 9216, ROFF_K2 = 18432, ROFF_V = 27648, ROFF_S = 92160, ROFF_ST = 101376, ROFF_PART = 119808, ROFF_STAT = 136192;
__device__ __forceinline__ void retention_unit(LAS unsigned char* lds, const Ptrs& P, int b, int h, int tid) {
    const int lane = tid & 63, w = __builtin_amdgcn_readfirstlane(tid >> 6), fr = lane & 15, fq = lane >> 4;
    const float lg = LG2[h];
    LAS bf16* Ss = (LAS bf16*)(lds + ROFF_S); LAS bf16* St = (LAS bf16*)(lds + ROFF_ST);
    LAS float* part = (LAS float*)(lds + ROFF_PART); LAS float* stat = (LAS float*)(lds + ROFF_STAT);
    for (int i = tid; i < 128 * S72 * 2 / 16; i += NTHREADS) ((LAS v4u*)St)[i] = (v4u){0u, 0u, 0u, 0u};
    f32x4 st[4];
#pragma unroll
    for (int i = 0; i < 4; ++i) st[i] = (f32x4){0.f, 0.f, 0.f, 0.f};
    const int lrow = tid >> 3, lseg = tid & 7, vrow0 = tid >> 4, vseg = tid & 15;
    const size_t tok0 = (size_t)b * SEQ;
    const bf16* gq = P.Q + (tok0 + lrow) * 256 + h * 64 + lseg * 8; const bf16* gk = P.K + (tok0 + lrow) * 256 + h * 64 + lseg * 8;
    const bf16* gv = P.V + (tok0 + vrow0) * 512 + h * 128 + vseg * 8;
    const bf16* gsl = P.SG + (tok0 + fr) * 512 + h * 128 + 16 * w + 4 * fq;
    bf16* gol = P.RS + (tok0 + fr) * 1024 + h * 128 + 16 * w + 4 * fq;
    v4u rq = *(const v4u*)gq, rk = *(const v4u*)gk, rv0 = *(const v4u*)gv, rv1 = *(const v4u*)(gv + 32 * 512);
    const float dkey = ex2((float)(63 - lrow) * lg), dch = ex2(64.f * lg);
    const f32x4 gng4 = *(const f32x4*)(P.gng + h * 128 + 16 * w + 4 * fq);
    const int it3 = w >> 1;
    float dqv[4]; f32x4 decv[2];
#pragma unroll
    for (int it = 0; it < 4; ++it) dqv[it] = ex2((float)(16 * it + fr + 1) * lg);
#pragma unroll
    for (int j2 = 0; j2 < 2; ++j2)
#pragma unroll
        for (int r = 0; r < 4; ++r) decv[j2][r] = ex2(__builtin_fabsf((float)((16 * it3 + fr) - (16 * ((w & 1) * 2 + j2) + 4 * fq + r))) * lg);
    f32x4 op[4]; v2u sgr[4];
#pragma unroll
    for (int it = 0; it < 4; ++it) { op[it] = (f32x4){0.f, 0.f, 0.f, 0.f}; sgr[it] = (v2u){0u, 0u}; }
    for (int n = 0; n <= 32; ++n) {
        LAS unsigned char* bufc = lds + (n & 1) * RSET;
        LAS bf16* Qs = (LAS bf16*)(bufc + ROFF_Q); LAS bf16* Ks = (LAS bf16*)(bufc + ROFF_K); LAS bf16* K2s = (LAS bf16*)(bufc + ROFF_K2); LAS bf16* Vs = (LAS bf16*)(bufc + ROFF_V);
        if (n < 32) {
            *(LAS v4u*)(Qs + lrow * S72 + lseg * 8) = rq; *(LAS v4u*)(Ks + lrow * S72 + lseg * 8) = rk;
            v4u k2;
#pragma unroll
            for (int t = 0; t < 4; ++t) k2[t] = pk2(bflo(rk[t]) * dkey, bfhi(rk[t]) * dkey);
            *(LAS v4u*)(K2s + lrow * S72 + lseg * 8) = k2;
            *(LAS v4u*)(Vs + vrow0 * S144 + vseg * 8) = rv0; *(LAS v4u*)(Vs + (vrow0 + 32) * S144 + vseg * 8) = rv1;
        }
        if (n >= 1) {
#pragma unroll
            for (int it = 0; it < 4; ++it) sgr[it] = *(const v2u*)(gsl + ((size_t)(n - 1) * 64 + 16 * it) * 512);
        }
        LBAR();
        if (n + 1 < 32) { const size_t o4 = (size_t)(n + 1) * 64;
            rq = *(const v4u*)(gq + o4 * 256); rk = *(const v4u*)(gk + o4 * 256); rv0 = *(const v4u*)(gv + o4 * 512); rv1 = *(const v4u*)(gv + (o4 + 32) * 512); }
        if (n >= 1) {
            const int row = tid >> 3, sub = tid & 7;
            const f32x4 pa = *(const LAS f32x4*)(part + (row * 32 + sub * 4) * 2), pb = *(const LAS f32x4*)(part + (row * 32 + sub * 4) * 2 + 4);
            float s1 = (pa[0] + pa[2]) + (pb[0] + pb[2]), s2 = (pa[1] + pa[3]) + (pb[1] + pb[3]);
#pragma unroll
            for (int x = 1; x < 8; x <<= 1) { s1 += __shfl_xor(s1, x); s2 += __shfl_xor(s2, x); }
            if (sub == 0) { const float mean = s1 * (1.f / 128.f); float var = s2 * (1.f / 128.f) - mean * mean; var = var < 0.f ? 0.f : var;
                stat[row * 2] = mean; stat[row * 2 + 1] = __builtin_amdgcn_rsqf(var + 1e-5f); }
        }
        if (n < 32) {
#pragma unroll
            for (int j2 = 0; j2 < 2; ++j2) {
                const int jt = (w & 1) * 2 + j2; f32x4 a4 = (f32x4){0.f, 0.f, 0.f, 0.f};
#pragma unroll
                for (int ks = 0; ks < 2; ++ks) {
                    const bf16x8 qf = *(const LAS bf16x8*)(Qs + (16 * it3 + fr) * S72 + 32 * ks + 8 * fq), kf = *(const LAS bf16x8*)(Ks + (16 * jt + fr) * S72 + 32 * ks + 8 * fq);
                    a4 = mfma16(kf, qf, a4); }
                a4 = a4 * decv[j2];
                v2u pw; pw.x = pk2(a4[0], a4[1]); pw.y = pk2(a4[2], a4[3]);
                *(LAS v2u*)(Ss + (16 * it3 + fr) * S72 + 16 * jt + 4 * fq) = pw;
            }
        }
        LBAR();
        if (n >= 1) {
#pragma unroll
            for (int it = 0; it < 4; ++it) { const int i = 16 * it + fr; const float mean = stat[i * 2], rstd = stat[i * 2 + 1]; const v2u sg = sgr[it];
                const f32x4 y = (op[it] - mean) * rstd * gng4 * (f32x4){bflo(sg.x), bfhi(sg.x), bflo(sg.y), bfhi(sg.y)};
                v2u pw; pw.x = pk2(y[0], y[1]); pw.y = pk2(y[2], y[3]);
                *(v2u*)(gol + ((size_t)(n - 1) * 64 + 16 * it) * 1024) = pw; }
        }
        if (n < 32) {
            f32x4 o[4]; bf16x8 bst[2], bv[2];
#pragma unroll
            for (int ks = 0; ks < 2; ++ks) { bst[ks] = *(const LAS bf16x8*)(St + (16 * w + fr) * S72 + 32 * ks + 8 * fq); bv[ks] = tr_frag(bufc + ROFF_V, S144 * 2, w, ks, fq, fr); }
#pragma unroll
            for (int it = 0; it < 4; ++it) { o[it] = (f32x4){0.f, 0.f, 0.f, 0.f};
#pragma unroll
                for (int ks = 0; ks < 2; ++ks) { const bf16x8 qf = *(const LAS bf16x8*)(Qs + (16 * it + fr) * S72 + 32 * ks + 8 * fq); o[it] = mfma16(bst[ks], qf, o[it]); }
                o[it] = o[it] * dqv[it];
#pragma unroll
                for (int ks = 0; ks < 2; ++ks) { const bf16x8 sf = *(const LAS bf16x8*)(Ss + (16 * it + fr) * S72 + 32 * ks + 8 * fq); o[it] = mfma16(bv[ks], sf, o[it]); }
            }
#pragma unroll
            for (int dt = 0; dt < 4; ++dt) { st[dt] = st[dt] * dch;
#pragma unroll
                for (int ks = 0; ks < 2; ++ks) { const bf16x8 kf = tr_frag(bufc + ROFF_K2, S72 * 2, dt, ks, fq, fr); st[dt] = mfma16(kf, bv[ks], st[dt]); }
                v2u pw; pw.x = pk2(st[dt][0], st[dt][1]); pw.y = pk2(st[dt][2], st[dt][3]);
                *(LAS v2u*)(St + (16 * w + fr) * S72 + 16 * dt + 4 * fq) = pw; }
#pragma unroll
            for (int it = 0; it < 4; ++it) { const f32x4 v = o[it]; typedef float f32x2 __attribute__((ext_vector_type(2)));
                *(LAS f32x2*)(part + ((16 * it + fr) * 32 + w * 4 + fq) * 2) = (f32x2){(v[0] + v[1]) + (v[2] + v[3]), (v[0] * v[0] + v[1] * v[1]) + (v[2] * v[2] + v[3] * v[3])};
                op[it] = v; }
        }
    }
    LBAR();
}

constexpr int POOL_US = 0, POOL_PS = 21504, POOL_YS = POOL_PS + 64 * S136 * 2;
#define POOL_LOAD(tile_) do { _Pragma("unroll") for (int k_ = 0; k_ < 3; ++k_) { const int idx_ = tid + 512 * k_, r_ = idx_ >> 4; \
        const bool ok_ = (idx_ < 79 * 16) && ((((tile_) & 31) != 0) || r_ >= 15); const long grow_ = (long)(tile_) * 64 - 15 + r_; \
        pf[k_] = ok_ ? *(const v4u*)(P.U + (size_t)grow_ * 512 + g * 128 + vseg * 8) : (v4u){0u, 0u, 0u, 0u}; } } while (0)
template <int WIN>
__device__ __forceinline__ void pool_block_t(LAS unsigned char* lds, const Ptrs& P, int g, int tile0, int tstep, int tid) {
    const int lane = tid & 63, w = __builtin_amdgcn_readfirstlane(tid >> 6), fr = lane & 15, fq = lane >> 4;
    LAS bf16* Us = (LAS bf16*)(lds + POOL_US); LAS bf16* Ps = (LAS bf16*)(lds + POOL_PS); LAS bf16* Ys = (LAS bf16*)(lds + POOL_YS);
    bf16x8 bw[4];
#pragma unroll
    for (int ks = 0; ks < 4; ++ks) bw[ks] = *(const bf16x8*)(P.WP + (size_t)(g * 128 + 16 * w + fr) * 128 + 32 * ks + 8 * fq);
    const int vrow0 = tid >> 4, vseg = tid & 15;
    v4u pf[3];
    POOL_LOAD(tile0);
    for (int tile = tile0; tile < M / 64; tile += tstep) {
#pragma unroll
        for (int k = 0; k < 3; ++k) { const int idx = tid + 512 * k; if (idx < 79 * 16) *(LAS v4u*)(Us + (idx >> 4) * S136 + vseg * 8) = pf[k]; }
        LBAR();
        if (tile + tstep < M / 64) POOL_LOAD(tile + tstep);
#pragma unroll
        for (int rep = 0; rep < 2; ++rep) {
            const int row = vrow0 + 32 * rep; const int pos = (tile * 64 + row) & 2047; const int cnt = (pos + 1 < WIN) ? pos + 1 : WIN;
            const v4u cur = *(const LAS v4u*)(Us + (row + 15) * S136 + vseg * 8); float a[8];
#pragma unroll
            for (int k = 0; k < 4; ++k) { a[2 * k] = bflo(cur[k]); a[2 * k + 1] = bfhi(cur[k]); }
#pragma unroll
            for (int tau = 1; tau < WIN; ++tau) { const v4u v = *(const LAS v4u*)(Us + (row + 15 - tau) * S136 + vseg * 8);
#pragma unroll
                for (int k = 0; k < 4; ++k) { a[2 * k] += bflo(v[k]); a[2 * k + 1] += bfhi(v[k]); } }
            const float inv = __builtin_amdgcn_rcpf((float)cnt); v4u o;
#pragma unroll
            for (int k = 0; k < 4; ++k) o[k] = pk2(a[2 * k] * inv - bflo(cur[k]), a[2 * k + 1] * inv - bfhi(cur[k]));
            *(LAS v4u*)(Ps + row * S136 + vseg * 8) = o;
        }
        LBAR();
#pragma unroll
        for (int it = 0; it < 4; ++it) { f32x4 acc = (f32x4){0.f, 0.f, 0.f, 0.f};
#pragma unroll
            for (int ks = 0; ks < 4; ++ks) { const bf16x8 a = *(const LAS bf16x8*)(Ps + (16 * it + fr) * S136 + 32 * ks + 8 * fq); acc = mfma16(bw[ks], a, acc); }
            v2u pw; pw.x = pk2(acc[0], acc[1]); pw.y = pk2(acc[2], acc[3]);
            *(LAS v2u*)(Ys + (16 * it + fr) * S136 + 16 * w + 4 * fq) = pw; }
        LBAR();
#pragma unroll
        for (int rep = 0; rep < 2; ++rep) { const int row = vrow0 + 32 * rep; const size_t t = (size_t)tile * 64 + row;
            *(v4u*)(P.RS + t * 1024 + 512 + g * 128 + vseg * 8) = *(const LAS v4u*)(Ys + row * S136 + vseg * 8); }
    }
    LBAR();
}
__device__ __forceinline__ void pool_block(LAS unsigned char* lds, const Ptrs& P, int pblk, int npblk, int tid) {
    const int g = pblk & 3, tile0 = pblk >> 2, tstep = npblk >> 2;
    if (g == 0) pool_block_t<2>(lds, P, g, tile0, tstep, tid);
    else if (g == 1) pool_block_t<4>(lds, P, g, tile0, tstep, tid);
    else if (g == 2) pool_block_t<8>(lds, P, g, tile0, tstep, tid);
    else pool_block_t<16>(lds, P, g, tile0, tstep, tid);
}
}

struct Args { const float* in[16]; float* out; unsigned char* ws; int ph_lo, ph_hi; };
__global__ void __launch_bounds__(NTHREADS, 2) mk_fwd(Args args) {
    extern __shared__ __attribute__((aligned(16))) unsigned char lds_raw[];
    LAS unsigned char* lds = (LAS unsigned char*)lds_raw;
    const int tid = threadIdx.x, lane = tid & 63, wave = __builtin_amdgcn_readfirstlane(tid >> 6);
    const int G = gridDim.x;
    unsigned char* ws = args.ws;
    Ptrs P;
    P.x = args.in[0]; P.n1 = args.in[1]; P.g1 = args.in[2]; P.u1 = args.in[3]; P.d1 = args.in[4]; P.nm = args.in[5]; P.win = args.in[6]; P.gng = args.in[7];
    P.pw = args.in[8]; P.ps = args.in[9]; P.wout = args.in[10]; P.n2 = args.in[11]; P.g2 = args.in[12]; P.u2 = args.in[13]; P.d2 = args.in[14]; P.nf = args.in[15];
    P.out = args.out;
    P.XB = (bf16*)(ws + WS_XB); P.ACT = (bf16*)(ws + WS_BIG); P.Q = (bf16*)(ws + WS_Q); P.K = (bf16*)(ws + WS_K); P.V = (bf16*)(ws + WS_V); P.SG = (bf16*)(ws + WS_SG);
    P.U = (bf16*)(ws + WS_U); P.RS = (bf16*)(ws + WS_RS);
    P.WGU1 = (bf16*)(ws + WS_WGU1); P.WD1 = (bf16*)(ws + WS_WD1); P.WGU2 = (bf16*)(ws + WS_WGU2); P.WD2 = (bf16*)(ws + WS_WD2); P.WIN = (bf16*)(ws + WS_WIN);
    P.WOUT = (bf16*)(ws + WS_WOUT); P.WP = (bf16*)(ws + WS_WP);
    P.SSQ = (float*)(ws + WS_SSQ); P.ROPEC = (float*)(ws + WS_ROPEC); P.ROPES = (float*)(ws + WS_ROPES);
    const int lo = args.ph_lo, hi = args.ph_hi;
    if (tid < 16) ((LAS unsigned*)(lds + LDS_BARST))[tid] = 0u;
    __syncthreads();
    XcdBarrier xbar; xbar.bar = (unsigned*)(ws + WS_CTL); xbar.x = 0; xbar.st = nullptr;
    if (hi - lo > 1) xbar = xcd_barrier_post((unsigned*)(ws + WS_CTL), (volatile LAS unsigned*)(lds + LDS_BARST));
#define IN(k) (lo <= (k) && (k) < hi)
#define SEAM(k) do { if (IN(k) && IN((k) + 1)) { xcd_barrier(xbar); } } while (0)

    if (lo < 0) cg::this_grid().sync();
    if (IN(0)) { REP(0) p0_prologue(P, lds, tid, lane, wave); SEAM(0); }
    if (IN(1)) {
        pg8::Gemm g{P.XB, P.WGU1, M, NGU, D}; pg8::StaticOrder S; S.init(M, NGU, G, (int)blockIdx.x);
        pg8::EpiSwiGLU E{P.ACT, P.SSQ};
        REP(1) pg8::gemm_phase<pg8::EpiSwiGLU, pg8::StaticOrder, true, true>(lds, g, S, E);
        SEAM(1);
    }
    if (IN(2)) {
        pg8::Gemm g{P.ACT, P.WD1, M, D, FF}; pg8::StaticOrder S; S.init(M, D, G, (int)blockIdx.x);
        pg8::EpiResid E{P.XB, P.XB, P.SSQ, 0.5f};
        REP(2) pg8::gemm_phase<pg8::EpiResid, pg8::StaticOrder, true, true, true>(lds, g, S, E);
        SEAM(2);
    }
    if (IN(3)) {
        pg8::Gemm g{P.XB, P.WIN, M, INW, D}; pg8::StaticOrder S; S.init(M, INW, G, (int)blockIdx.x);
        pg8::EpiWin E{P.Q, P.V, P.SSQ, P.ROPEC, P.ROPES};
        REP(3) pg8::gemm_phase<pg8::EpiWin, pg8::StaticOrder, true, true>(lds, g, S, E);
        SEAM(3);
    }
    if (IN(4)) {
        const int bx = blockIdx.x;
        REP(4)
        if (G >= 8) {
            const int npool = (G / 2) & ~3, nret = G - npool;
            if (bx < nret) {
#if MK_NO_RET
                for (size_t i = (size_t)bx * NTHREADS + tid; i < (size_t)M * 64; i += (size_t)nret * NTHREADS) *(v4u*)(P.RS + (i >> 6) * 1024 + (i & 63) * 8) = (v4u){0u, 0u, 0u, 0u};
#else
                for (int u = bx; u < BATCH * 4; u += nret) mix::retention_unit(lds, P, u >> 2, u & 3, tid);
#endif
            } else {
#if MK_NO_POOL
                for (size_t i = (size_t)(bx - nret) * NTHREADS + tid; i < (size_t)M * 64; i += (size_t)npool * NTHREADS) *(v4u*)(P.RS + (i >> 6) * 1024 + 512 + (i & 63) * 8) = (v4u){0u, 0u, 0u, 0u};
#else
                mix::pool_block(lds, P, bx - nret, npool, tid);
#endif
            }
        } else {
            for (int u = bx; u < BATCH * 4; u += G) mix::retention_unit(lds, P, u >> 2, u & 3, tid);
            for (int pb = bx; pb < 4 * G; pb += G) mix::pool_block(lds, P, pb, 4 * G, tid);
        }
        SEAM(4);
    }
    if (IN(5)) {
        pg8::Gemm g{P.RS, P.WOUT, M, D, D}; pg8::StaticOrder S; S.init(M, D, G, (int)blockIdx.x);
        pg8::EpiResid E{P.XB, P.XB, P.SSQ, 1.0f};
        pg8::gemm_phase<pg8::EpiResid, pg8::StaticOrder, true, true>(lds, g, S, E);
        SEAM(5);
    }
    if (IN(6)) {
        pg8::Gemm g{P.XB, P.WGU2, M, NGU, D}; pg8::StaticOrder S; S.init(M, NGU, G, (int)blockIdx.x);
        pg8::EpiSwiGLU E{P.ACT, P.SSQ};
        REP(6) pg8::gemm_phase<pg8::EpiSwiGLU, pg8::StaticOrder, true, true>(lds, g, S, E);
        SEAM(6);
    }
    if (IN(7)) {
        pg8::Gemm g{P.ACT, P.WD2, M, D, FF}; pg8::StaticOrder S; S.init(M, D, G, (int)blockIdx.x);
        pg8::EpiFinalNorm E{P.XB, P.out, P.nf, (unsigned*)(ws + WS_XBUF), (unsigned*)(ws + WS_CTL + CTL_CNT), lds + pg8::STAGE_BYTES, 0.5f};
        pg8::gemm_phase<pg8::EpiFinalNorm, pg8::StaticOrder, true, true, true>(lds, g, S, E);
    }
#undef IN
#undef SEAM
}

extern "C" void kernel_launch(void* const* d_in, const int* in_sizes, int n_in, void* d_out, int out_size, void* d_ws, size_t ws_size, hipStream_t stream) {
    static int grid = 0;
    if (grid == 0) {
        if (n_in != 16 || in_sizes[0] != M * D || out_size != M * D || ws_size < WS_END) { fprintf(stderr, "kernel_launch: unexpected shapes (n_in %d, in0 %d, out %d, ws %zu); nothing launched\n", n_in, n_in > 0 ? in_sizes[0] : -1, out_size, ws_size); grid = -1; return; }
        int dev = 0, cus = 0, per_cu = 0;
        if (hipGetDevice(&dev) != hipSuccess || hipDeviceGetAttribute(&cus, hipDeviceAttributeMultiprocessorCount, dev) != hipSuccess) { grid = -1; return; }
        if (hipFuncSetAttribute((const void*)mk_fwd, hipFuncAttributeMaxDynamicSharedMemorySize, LDS_BYTES) != hipSuccess) { fprintf(stderr, "kernel_launch: hipFuncSetAttribute failed\n"); grid = -1; return; }
        if (hipOccupancyMaxActiveBlocksPerMultiprocessor(&per_cu, (const void*)mk_fwd, NTHREADS, LDS_BYTES) != hipSuccess || per_cu < 1) { fprintf(stderr, "kernel_launch: occupancy query gave %d\n", per_cu); per_cu = 1; }
        (void)hipGetLastError();
        grid = cus * per_cu;
    }
    if (grid < 0) return;
    Args a{};
    for (int i = 0; i < 16; ++i) a.in[i] = (const float*)d_in[i];
    a.out = (float*)d_out; a.ws = (unsigned char*)d_ws;
#if MK_N_LAUNCHES == 1
    if (hipMemsetAsync((char*)d_ws + WS_CTL, 0, CTL_BYTES, stream) != hipSuccess) { fprintf(stderr, "kernel_launch: hipMemsetAsync failed\n"); return; }
    a.ph_lo = 0; a.ph_hi = NPHASE;
    void* kargs[] = {&a};
    const hipError_t le = hipLaunchCooperativeKernel((const void*)mk_fwd, dim3(grid), dim3(NTHREADS), kargs, LDS_BYTES, stream);
    if (le != hipSuccess) fprintf(stderr, "kernel_launch: cooperative launch failed: %s (grid %d)\n", hipGetErrorString(le), grid);
#else
    for (int ph = 0; ph < NPHASE; ++ph) {
        if (MK_SKIP_MASK & (1 << ph)) continue;
        a.ph_lo = ph; a.ph_hi = ph + 1;
        hipLaunchKernelGGL(mk_fwd, dim3(grid), dim3(NTHREADS), LDS_BYTES, stream, a);
    }
#endif
}
```

```cpp
#include <hip/hip_runtime.h>
#include <hip/hip_cooperative_groups.h>
#include <cstdio>
#include <cstdint>
namespace cg = cooperative_groups;
namespace pg8 {
#define PG8_LAS __attribute__((address_space(3)))
typedef unsigned short bf16_t;
typedef short bf16x8 __attribute__((ext_vector_type(8)));
typedef float f32x4 __attribute__((ext_vector_type(4)));
typedef unsigned u32x4 __attribute__((ext_vector_type(4)));
constexpr int BM = 256, BK = 64, HALF = 128, HTB = HALF * BK * 2  , STAGE_BYTES = 8 * HTB, NXCD = 8, WGM = 8;

__host__ __device__ __forceinline__ int lds_byte(int r, int c) { const int st = (r >> 4) * 2 + (c >> 5), rr = r & 15, cc = c & 31, ob = rr * 64 + cc * 2; return st * 1024 + (ob ^ (((ob >> 9) & 1) << 5)); }
__host__ __device__ __forceinline__ void stage_rc(int b, int& R, int& C) { const int st = b / 1024, sb = b % 1024, swz = sb ^ (((sb >> 9) & 1) << 5); R = (st >> 1) * 16 + swz / 64; C = (st & 1) * 32 + (swz % 64) / 2; }
__host__ __device__ __forceinline__ int perm32(int rho) { const int n = rho >> 4, i = rho & 15; return 8 * (i >> 2) + 4 * n + (i & 3); }

struct Unit { int pm, pn; };
struct Gemm { const bf16_t* A; const bf16_t* Bt; int M, N, K; };

struct StaticOrder {
    int nM, nN, nwg, G, c;
    __host__ __device__ void init(int M, int N, int G_, int c_) { nM = M / BM; nN = N / BM; nwg = nM * nN; G = G_; c = c_; }
    __host__ __device__ bool next(int i, Unit& u) const {
        const long L = (long)i * G + c; if (L >= nwg) return false;
        int wgid = (int)L; { const int q = nwg / NXCD, r = nwg % NXCD, xcd = wgid % NXCD, off = wgid / NXCD; wgid = (xcd < r ? xcd * (q + 1) : r * (q + 1) + (xcd - r) * q) + off; }
        const int nig = WGM * nN, gid = wgid / nig, fm = gid * WGM, gsz = (nM - fm) < WGM ? (nM - fm) : WGM;
        u.pm = fm + ((wgid % nig) % gsz); u.pn = (wgid % nig) / gsz; return true;
    }
    __device__ __forceinline__ void a_ready(const Unit&) const {}
    __device__ __forceinline__ void done(const Unit&) const {}
};

typedef __bf16 bf16v2 __attribute__((ext_vector_type(2)));
__device__ __forceinline__ unsigned cvt_pk_bf16(float lo, float hi) { typedef float f2 __attribute__((ext_vector_type(2))); const bf16v2 r = __builtin_convertvector((f2){lo, hi}, bf16v2); return __builtin_bit_cast(unsigned, r); }
typedef float f32x2 __attribute__((ext_vector_type(2)));
typedef unsigned u32x2 __attribute__((ext_vector_type(2)));
constexpr int DM = 1024, DFF = 2816;
constexpr float RMS_EPS = 1e-6f;
__device__ __forceinline__ float row_rstd(const float* ssq, int row, int fq) {
    const f32x4 p = *(const f32x4*)(ssq + (size_t)row * 16 + 4 * fq);
    float s = (p[0] + p[1]) + (p[2] + p[3]);
    s += __shfl_xor(s, 16); s += __shfl_xor(s, 32);
    return __builtin_amdgcn_rsqf(s * (1.0f / (float)DM) + RMS_EPS);
}
__device__ __forceinline__ float silu_f(float x) { return x * __builtin_amdgcn_rcpf(1.0f + __builtin_amdgcn_exp2f(-1.4426950408889634f * x)); }
__device__ __forceinline__ f32x4 silu4(f32x4 v) { return (f32x4){silu_f(v[0]), silu_f(v[1]), silu_f(v[2]), silu_f(v[3])}; }

__device__ __forceinline__ void rows_rstd(const float* ssq, int row0, int fq, float (&rs)[2][4]) {
    f32x4 p[2][4];
#pragma unroll
    for (int ai = 0; ai < 2; ++ai)
#pragma unroll
        for (int m = 0; m < 4; ++m) p[ai][m] = *(const f32x4*)(ssq + (size_t)(row0 + ai * HALF + m * 16) * 16 + 4 * fq);
#pragma unroll
    for (int ai = 0; ai < 2; ++ai)
#pragma unroll
        for (int m = 0; m < 4; ++m) { float s = (p[ai][m][0] + p[ai][m][1]) + (p[ai][m][2] + p[ai][m][3]); s += __shfl_xor(s, 16); s += __shfl_xor(s, 32); rs[ai][m] = __builtin_amdgcn_rsqf(s * (1.0f / (float)DM) + RMS_EPS); }
}
struct EpiSwiGLU {
    static constexpr bool PERM = true, AFTER_DRAIN = false;
    bf16_t* O; const float* ssq;
    __device__ __forceinline__ void operator()(const f32x4 (&acc)[2][2][4][2], const Unit& u, int wr, int wc, int fr, int fq) const {
        const int row0 = u.pm * BM + wr * 64 + fr, col0 = u.pn * HALF + wc * 32 + 8 * fq;
        float rsv[2][4]; rows_rstd(ssq, row0, fq, rsv);
#pragma unroll
        for (int ai = 0; ai < 2; ++ai)
#pragma unroll
            for (int m = 0; m < 4; ++m) {
                const int row = row0 + ai * HALF + m * 16; const float rs = rsv[ai][m];
                const f32x4 g0 = acc[ai][0][m][0] * rs, g1 = acc[ai][0][m][1] * rs, u0 = acc[ai][1][m][0] * rs, u1 = acc[ai][1][m][1] * rs;
                const f32x4 a0 = silu4(g0) * u0, a1 = silu4(g1) * u1;
                u32x4 w; w.x = cvt_pk_bf16(a0[0], a0[1]); w.y = cvt_pk_bf16(a0[2], a0[3]); w.z = cvt_pk_bf16(a1[0], a1[1]); w.w = cvt_pk_bf16(a1[2], a1[3]);
                *(u32x4*)(O + (((size_t)(row >> 8) * (DFF / BK) + (col0 >> 6)) * BM + (row & 255)) * BK + (col0 & 63)) = w;
            }
    }
};
__device__ __forceinline__ void bf8_to_f32(const u32x4 w, f32x4& lo, f32x4& hi) {
    lo = (f32x4){__builtin_bit_cast(float, w.x << 16), __builtin_bit_cast(float, w.x & 0xffff0000u), __builtin_bit_cast(float, w.y << 16), __builtin_bit_cast(float, w.y & 0xffff0000u)};
    hi = (f32x4){__builtin_bit_cast(float, w.z << 16), __builtin_bit_cast(float, w.z & 0xffff0000u), __builtin_bit_cast(float, w.w << 16), __builtin_bit_cast(float, w.w & 0xffff0000u)};
}
struct EpiResid {
    static constexpr bool PERM = true, AFTER_DRAIN = false;
    const bf16_t* base; bf16_t* xb; float* ssq; float alpha;
    __device__ __forceinline__ void operator()(const f32x4 (&acc)[2][2][4][2], const Unit& u, int wr, int wc, int fr, int fq) const {
        const int row0 = u.pm * BM + wr * 64 + fr, col0 = u.pn * BM + wc * 32 + 8 * fq;
#pragma unroll
        for (int ai = 0; ai < 2; ++ai) {
            u32x4 pre[4][2];
#pragma unroll
            for (int m = 0; m < 4; ++m)
#pragma unroll
                for (int bj = 0; bj < 2; ++bj) pre[m][bj] = *(const u32x4*)(base + (size_t)(row0 + ai * HALF + m * 16) * DM + col0 + bj * HALF);
#pragma unroll
            for (int m = 0; m < 4; ++m) {
                const int row = row0 + ai * HALF + m * 16; float q = 0.f;
#pragma unroll
                for (int bj = 0; bj < 2; ++bj) {
                    const size_t off = (size_t)row * DM + col0 + bj * HALF;
                    f32x4 b0, b1; bf8_to_f32(pre[m][bj], b0, b1);
                    const f32x4 o0 = b0 + acc[ai][bj][m][0] * alpha, o1 = b1 + acc[ai][bj][m][1] * alpha;
                    u32x4 w; w.x = cvt_pk_bf16(o0[0], o0[1]); w.y = cvt_pk_bf16(o0[2], o0[3]); w.z = cvt_pk_bf16(o1[0], o1[1]); w.w = cvt_pk_bf16(o1[2], o1[3]); *(u32x4*)(xb + off) = w;
                    q += (o0[0] * o0[0] + o0[1] * o0[1]) + (o0[2] * o0[2] + o0[3] * o0[3]) + (o1[0] * o1[0] + o1[1] * o1[1]) + (o1[2] * o1[2] + o1[3] * o1[3]);
                }
                q += __shfl_xor(q, 16); q += __shfl_xor(q, 32);
                if (fq == 0) ssq[(size_t)row * 16 + u.pn * 4 + wc] = q;
            }
        }
    }
};
struct EpiFinalNorm {
    static constexpr bool PERM = true, AFTER_DRAIN = false;
    const bf16_t* base; float* out; const float* gain; unsigned* xbuf; unsigned* cnt; PG8_LAS unsigned char* xl; float alpha;
    __device__ __forceinline__ void operator()(f32x4 (&acc)[2][2][4][2], const Unit& u, int wr, int wc, int fr, int fq) const {
        const int wid = wr * 4 + wc, lane = fq * 16 + fr;
        PG8_LAS float* Pt = (PG8_LAS float*)xl; PG8_LAS float* Sr = (PG8_LAS float*)(xl + 4096);
        const int row0 = u.pm * BM + wr * 64 + fr, col0 = u.pn * BM + wc * 32 + 8 * fq;
        f32x4 gv[2][2];
#pragma unroll
        for (int bj = 0; bj < 2; ++bj)
#pragma unroll
            for (int n = 0; n < 2; ++n) gv[bj][n] = *(const f32x4*)(gain + col0 + bj * HALF + 4 * n);
#pragma unroll
        for (int ai = 0; ai < 2; ++ai) {
            u32x4 pre[4][2];
#pragma unroll
            for (int m = 0; m < 4; ++m)
#pragma unroll
                for (int bj = 0; bj < 2; ++bj) pre[m][bj] = *(const u32x4*)(base + (size_t)(row0 + ai * HALF + m * 16) * DM + col0 + bj * HALF);
#pragma unroll
            for (int m = 0; m < 4; ++m) { float q = 0.f;
#pragma unroll
                for (int bj = 0; bj < 2; ++bj) {
                    f32x4 b0, b1; bf8_to_f32(pre[m][bj], b0, b1);
                    const f32x4 o0 = b0 + acc[ai][bj][m][0] * alpha, o1 = b1 + acc[ai][bj][m][1] * alpha;
                    acc[ai][bj][m][0] = o0; acc[ai][bj][m][1] = o1;
                    q += (o0[0] * o0[0] + o0[1] * o0[1]) + (o0[2] * o0[2] + o0[3] * o0[3]) + (o1[0] * o1[0] + o1[1] * o1[1]) + (o1[2] * o1[2] + o1[3] * o1[3]);
                }
                q += __shfl_xor(q, 16); q += __shfl_xor(q, 32);
                if (fq == 0) Pt[(ai * HALF + wr * 64 + m * 16 + fr) * 4 + wc] = q;
            }
        }
        asm volatile("s_waitcnt lgkmcnt(0)" ::: "memory"); __builtin_amdgcn_s_barrier(); asm volatile("" ::: "memory");
        const int row = wid * 32 + (lane & 31);
        if (lane < 32) { const f32x4 p = *(const PG8_LAS f32x4*)(Pt + row * 4);
            __hip_atomic_store(xbuf + (size_t)(u.pm * BM + row) * 4 + u.pn, __builtin_bit_cast(unsigned, (p[0] + p[1]) + (p[2] + p[3])), __ATOMIC_RELAXED, __HIP_MEMORY_SCOPE_AGENT); }
        asm volatile("s_waitcnt vmcnt(0)" ::: "memory");
        if (lane == 0) __hip_atomic_fetch_add(cnt + 64 * u.pm, 1u, __ATOMIC_RELAXED, __HIP_MEMORY_SCOPE_AGENT);
        if (wid == 0) {
            unsigned spins = 0u;
            while ((unsigned)__builtin_amdgcn_readfirstlane(__hip_atomic_load(cnt + 64 * u.pm, __ATOMIC_RELAXED, __HIP_MEMORY_SCOPE_AGENT)) < 32u) { __builtin_amdgcn_s_sleep(2); if (++spins > (1u << 22)) break; }
            __builtin_amdgcn_fence(__ATOMIC_ACQUIRE, "agent");
        }
        asm volatile("s_waitcnt vmcnt(0) lgkmcnt(0)" ::: "memory"); __builtin_amdgcn_s_barrier(); asm volatile("" ::: "memory");
        if (lane < 32) { const unsigned* slot = xbuf + (size_t)(u.pm * BM + row) * 4; float t = 0.f;
#pragma unroll
            for (int k = 0; k < 4; ++k) t += __builtin_bit_cast(float, __hip_atomic_load(slot + k, __ATOMIC_RELAXED, __HIP_MEMORY_SCOPE_AGENT));
            Sr[row] = __builtin_amdgcn_rsqf(t * (1.0f / (float)DM) + RMS_EPS); }
        asm volatile("s_waitcnt lgkmcnt(0)" ::: "memory"); __builtin_amdgcn_s_barrier(); asm volatile("" ::: "memory");
#pragma unroll
        for (int ai = 0; ai < 2; ++ai)
#pragma unroll
            for (int m = 0; m < 4; ++m) { const float rs = Sr[ai * HALF + wr * 64 + m * 16 + fr];
#pragma unroll
                for (int bj = 0; bj < 2; ++bj) { const size_t off = (size_t)(row0 + ai * HALF + m * 16) * DM + col0 + bj * HALF;
                    *(f32x4*)(out + off) = acc[ai][bj][m][0] * rs * gv[bj][0]; *(f32x4*)(out + off + 4) = acc[ai][bj][m][1] * rs * gv[bj][1]; } }
    }
};
struct EpiWin {
    static constexpr bool PERM = true, AFTER_DRAIN = false;
    bf16_t *Q, *V; const float* ssq; const float* ropec; const float* ropes;
    __device__ __forceinline__ void operator()(const f32x4 (&acc)[2][2][4][2], const Unit& u, int wr, int wc, int fr, int fq) const {
        const int row0 = u.pm * BM + wr * 64 + fr, pn = u.pn;
        float rsv[2][4]; rows_rstd(ssq, row0, fq, rsv);
        if (pn < 2) {
            const int i0 = 16 * (wc & 1) + 4 * fq; const float qs = pn == 0 ? 0.125f : 1.0f;
#pragma unroll
            for (int ai = 0; ai < 2; ++ai) {
                f32x4 cc[4], ss[4];
#pragma unroll
                for (int m = 0; m < 4; ++m) { const int pos = (row0 + ai * HALF + m * 16) & 2047; cc[m] = *(const f32x4*)(ropec + pos * 32 + i0); ss[m] = *(const f32x4*)(ropes + pos * 32 + i0); }
#pragma unroll
                for (int m = 0; m < 4; ++m) {
                    const int row = row0 + ai * HALF + m * 16; const float sc = qs * rsv[ai][m];
                    bf16_t* dst = Q + (size_t)pn * (16u << 20) + (size_t)row * 256;
#pragma unroll
                    for (int bj = 0; bj < 2; ++bj) {
                        const int head = 2 * bj + (wc >> 1);
                        const f32x4 x1 = acc[ai][bj][m][0] * sc, x2 = acc[ai][bj][m][1] * sc;
                        const f32x4 o1 = x1 * cc[m] - x2 * ss[m], o2 = x1 * ss[m] + x2 * cc[m];
                        u32x2 w1, w2; w1.x = cvt_pk_bf16(o1[0], o1[1]); w1.y = cvt_pk_bf16(o1[2], o1[3]); w2.x = cvt_pk_bf16(o2[0], o2[1]); w2.y = cvt_pk_bf16(o2[2], o2[3]);
                        *(u32x2*)(dst + head * 64 + i0) = w1; *(u32x2*)(dst + head * 64 + 32 + i0) = w2;
                    }
                }
            }
        } else {
            const bool act = (pn == 4 || pn == 5);
#pragma unroll
            for (int ai = 0; ai < 2; ++ai)
#pragma unroll
                for (int m = 0; m < 4; ++m) {
                    const int row = row0 + ai * HALF + m * 16; const float rs = rsv[ai][m];
                    bf16_t* dst = V + (size_t)((pn - 2) >> 1) * (32u << 20) + (size_t)row * 512 + (pn & 1) * 256 + wc * 32 + 8 * fq;
#pragma unroll
                    for (int bj = 0; bj < 2; ++bj) {
                        f32x4 v0 = acc[ai][bj][m][0] * rs, v1 = acc[ai][bj][m][1] * rs;
                        if (act) { v0 = silu4(v0); v1 = silu4(v1); }
                        u32x4 w; w.x = cvt_pk_bf16(v0[0], v0[1]); w.y = cvt_pk_bf16(v0[2], v0[3]); w.z = cvt_pk_bf16(v1[0], v1[1]); w.w = cvt_pk_bf16(v1[2], v1[3]);
                        *(u32x4*)(dst + bj * HALF) = w;
                    }
                }
        }
    }
};

template <class Epi, class Sched, bool ALIGN_EPI = false, bool SP2 = false, bool ATILED = false>
__device__ __forceinline__ void gemm_phase(PG8_LAS unsigned char* lds, const Gemm g, const Sched& S, const Epi& E) {
    const int tid = threadIdx.x, wid = __builtin_amdgcn_readfirstlane(tid >> 6), lane = tid & 63, wr = wid >> 2, wc = wid & 3, fr = lane & 15, fq = lane >> 4;
    const int K = g.K, nt = K / BK;
    unsigned voffA[2], voffB[2];
#pragma unroll
    for (int i = 0; i < 2; ++i) { int R, C; stage_rc(tid * 16 + i * 8192, R, C); const int Rb = Epi::PERM ? ((R & ~31) + perm32(R & 31)) : R;
        voffA[i] = (unsigned)(R * (ATILED ? BK : K) + C) * 2u; voffB[i] = (unsigned)(Rb * K + C) * 2u; }
    const size_t kstep = (size_t)(BK * 2);
    const size_t hstep = (size_t)HALF * K * 2;
    const size_t tstep = 2 * hstep;
    const size_t kstepA = ATILED ? (size_t)(BM * BK * 2) : kstep, hstepA = ATILED ? (size_t)(HALF * BK * 2) : hstep, tstepA = ATILED ? (size_t)nt * (BM * BK * 2) : tstep;
    const unsigned ldsw = (unsigned)wid * 1024u;
    const int aoff = lds_byte(wr * 64 + fr, fq * 8), boff = lds_byte(wc * 32 + fr, fq * 8);
#define PG8_SA(b, h) (((b) * 2 + (h)) * HTB)
#define PG8_SB(b, h) ((4 + (b) * 2 + (h)) * HTB)
#define PG8_STAGE(bufoff, gbase, voff) do { _Pragma("unroll") for (int _i = 0; _i < 2; ++_i) \
        __builtin_amdgcn_global_load_lds((const unsigned*)((const char*)(gbase) + (voff)[_i]), (PG8_LAS unsigned*)(lds + (bufoff) + ldsw + _i * 8192), 16, 0, 0); } while (0)
#define PG8_LDA(dst, b, h) do { _Pragma("unroll") for (int m = 0; m < 4; ++m) _Pragma("unroll") for (int k = 0; k < 2; ++k) dst[m][k] = *(const PG8_LAS bf16x8*)(lds + PG8_SA(b, h) + aoff + m * 2048 + k * 1024); } while (0)
#define PG8_LDB(dst, b, h) do { _Pragma("unroll") for (int n = 0; n < 2; ++n) _Pragma("unroll") for (int k = 0; k < 2; ++k) dst[n][k] = *(const PG8_LAS bf16x8*)(lds + PG8_SB(b, h) + boff + n * 2048 + k * 1024); } while (0)
#define PG8_MMA(ai, bj, At, Bt) do { __builtin_amdgcn_s_setprio(1); _Pragma("unroll") for (int m = 0; m < 4; ++m) _Pragma("unroll") for (int n = 0; n < 2; ++n) _Pragma("unroll") for (int k = 0; k < 2; ++k) \
        acc[ai][bj][m][n] = __builtin_amdgcn_mfma_f32_16x16x32_bf16(Bt[n][k], At[m][k], acc[ai][bj][m][n], 0, 0, 0); __builtin_amdgcn_s_setprio(0); } while (0)
#define PG8_WAIT_V(n) asm volatile("s_waitcnt vmcnt(" #n ")" ::: "memory")
#define PG8_WAIT_L(n) asm volatile("s_waitcnt lgkmcnt(" #n ")" ::: "memory")
#define PG8_BAR __builtin_amdgcn_s_barrier()
#define PG8_SCHED __builtin_amdgcn_sched_barrier(0)
    Unit cur, nxt; int ui = 0;
    if (!S.next(0, cur)) return;
    f32x4 acc[2][2][4][2];
#pragma unroll
    for (int a = 0; a < 2; ++a)
#pragma unroll
        for (int b = 0; b < 2; ++b)
#pragma unroll
            for (int m = 0; m < 4; ++m)
#pragma unroll
                for (int n = 0; n < 2; ++n) acc[a][b][m][n] = (f32x4){0.f, 0.f, 0.f, 0.f};
    bf16x8 At[4][2], B0[2][2], B1[2][2];
    const char* cA = (const char*)g.A + (size_t)cur.pm * tstepA; const char* cB = (const char*)g.Bt + (size_t)cur.pn * tstep;
    S.a_ready(cur);
    if constexpr (SP2) {
        PG8_STAGE(PG8_SB(0, 0), cB, voffB); PG8_STAGE(PG8_SB(0, 1), cB + hstep, voffB); PG8_STAGE(PG8_SA(0, 0), cA, voffA); PG8_STAGE(PG8_SA(0, 1), cA + hstepA, voffA);
        if (wr == 1) PG8_BAR;
        PG8_WAIT_V(2); PG8_BAR;
        PG8_STAGE(PG8_SB(1, 0), cB + kstep, voffB); PG8_STAGE(PG8_SA(1, 0), cA + kstepA, voffA); PG8_STAGE(PG8_SB(1, 1), cB + hstep + kstep, voffB);
        PG8_WAIT_V(6); PG8_BAR;
    } else {
        PG8_STAGE(PG8_SB(0, 0), cB, voffB); PG8_STAGE(PG8_SA(0, 0), cA, voffA); PG8_STAGE(PG8_SB(0, 1), cB + hstep, voffB); PG8_STAGE(PG8_SA(0, 1), cA + hstepA, voffA);
        if (wr == 1) PG8_BAR;
        PG8_WAIT_V(4); PG8_BAR;
        PG8_STAGE(PG8_SB(1, 0), cB + kstep, voffB); PG8_STAGE(PG8_SA(1, 0), cA + kstepA, voffA); PG8_STAGE(PG8_SB(1, 1), cB + hstep + kstep, voffB);
        PG8_WAIT_V(6); PG8_BAR;
    }
    for (;;) {
        const bool has_next = S.next(ui + 1, nxt);
        const char* nA = has_next ? (const char*)g.A + (size_t)nxt.pm * tstepA : cA; const char* nB = has_next ? (const char*)g.Bt + (size_t)nxt.pn * tstep : cB;
        for (int t = 0; t < nt; t += 2) {
            const bool last = (t == nt - 2);
            const char* a1 = cA + (size_t)(t + 1) * kstepA;
            const char* a2 = last ? nA : cA + (size_t)(t + 2) * kstepA; const char* b2 = last ? nB : cB + (size_t)(t + 2) * kstep;
            const char* a3 = a2 + kstepA; const char* b3 = b2 + kstep;
            if (last && has_next) S.a_ready(nxt);
            if constexpr (SP2) {
            PG8_LDB(B0, 0, 0); PG8_LDB(B1, 0, 1); PG8_SCHED; PG8_LDA(At, 0, 0); PG8_STAGE(PG8_SA(1, 1), a1 + hstepA, voffA);
            PG8_WAIT_V(8); PG8_WAIT_L(0); PG8_BAR; PG8_MMA(0, 0, At, B0); PG8_MMA(0, 1, At, B1); PG8_BAR; PG8_SCHED;
            PG8_LDA(At, 0, 1); PG8_STAGE(PG8_SB(0, 0), b2, voffB); PG8_STAGE(PG8_SB(0, 1), b2 + hstep, voffB); PG8_STAGE(PG8_SA(0, 0), a2, voffA);
            PG8_WAIT_V(8); PG8_WAIT_L(0); PG8_BAR; PG8_MMA(1, 0, At, B0); PG8_MMA(1, 1, At, B1); PG8_BAR; PG8_SCHED;
            PG8_LDB(B0, 1, 0); PG8_LDB(B1, 1, 1); PG8_SCHED; PG8_LDA(At, 1, 0); PG8_STAGE(PG8_SA(0, 1), a2 + hstepA, voffA);
            PG8_WAIT_V(8); PG8_WAIT_L(0); PG8_BAR; PG8_MMA(0, 0, At, B0); PG8_MMA(0, 1, At, B1); PG8_BAR; PG8_SCHED;
            PG8_LDA(At, 1, 1); PG8_STAGE(PG8_SB(1, 0), b3, voffB); PG8_STAGE(PG8_SB(1, 1), b3 + hstep, voffB); PG8_STAGE(PG8_SA(1, 0), a3, voffA);
            PG8_WAIT_V(8); PG8_WAIT_L(0); PG8_BAR; PG8_MMA(1, 0, At, B0); PG8_MMA(1, 1, At, B1); PG8_BAR; PG8_SCHED;
            } else {
            PG8_LDB(B0, 0, 0); PG8_SCHED; PG8_LDA(At, 0, 0); PG8_STAGE(PG8_SA(1, 1), a1 + hstepA, voffA);
            PG8_WAIT_L(8); PG8_BAR; PG8_WAIT_L(0); PG8_MMA(0, 0, At, B0); PG8_BAR; PG8_SCHED;
            PG8_LDB(B1, 0, 1); PG8_STAGE(PG8_SB(0, 0), b2, voffB);
            PG8_BAR; PG8_WAIT_L(0); PG8_MMA(0, 1, At, B1); PG8_BAR;
            PG8_LDA(At, 0, 1); PG8_STAGE(PG8_SA(0, 0), a2, voffA);
            PG8_BAR; PG8_WAIT_L(0); PG8_MMA(1, 0, At, B0); PG8_BAR; PG8_SCHED;
            PG8_STAGE(PG8_SB(0, 1), b2 + hstep, voffB);
            PG8_WAIT_V(6); PG8_BAR; PG8_MMA(1, 1, At, B1); PG8_BAR;
            PG8_LDB(B0, 1, 0); PG8_SCHED; PG8_LDA(At, 1, 0); PG8_STAGE(PG8_SA(0, 1), a2 + hstepA, voffA);
            PG8_WAIT_L(8); PG8_BAR; PG8_WAIT_L(0); PG8_MMA(0, 0, At, B0); PG8_BAR; PG8_SCHED;
            PG8_LDB(B1, 1, 1); PG8_STAGE(PG8_SB(1, 0), b3, voffB);
            PG8_BAR; PG8_WAIT_L(0); PG8_MMA(0, 1, At, B1); PG8_BAR;
            PG8_LDA(At, 1, 1); PG8_STAGE(PG8_SA(1, 0), a3, voffA);
            PG8_BAR; PG8_WAIT_L(0); PG8_MMA(1, 0, At, B0); PG8_BAR; PG8_SCHED;
            PG8_STAGE(PG8_SB(1, 1), b3 + hstep, voffB);
            PG8_WAIT_V(6); PG8_BAR; PG8_MMA(1, 1, At, B1); PG8_BAR;
            }
        }
        if constexpr (ALIGN_EPI) { if (wr == 0) PG8_BAR; }
        if constexpr (!Epi::AFTER_DRAIN) { E(acc, cur, wr, wc, fr, fq); S.done(cur); }
        if (!has_next) break;
#pragma unroll
        for (int a = 0; a < 2; ++a)
#pragma unroll
            for (int b = 0; b < 2; ++b)
#pragma unroll
                for (int m = 0; m < 4; ++m)
#pragma unroll
                    for (int n = 0; n < 2; ++n) acc[a][b][m][n] = (f32x4){0.f, 0.f, 0.f, 0.f};
        cur = nxt; cA = nA; cB = nB; ++ui;
        if constexpr (ALIGN_EPI) { if (wr == 1) PG8_BAR; }
    }
    PG8_WAIT_V(0);
    if constexpr (!ALIGN_EPI) { if (wr == 0) PG8_BAR; }
    PG8_BAR;
    if constexpr (Epi::AFTER_DRAIN) { E.fused(acc, cur, wr, wc, fr, fq, lds, wid, lane); S.done(cur); }
#undef PG8_SA
#undef PG8_SB
#undef PG8_STAGE
#undef PG8_LDA
#undef PG8_LDB
#undef PG8_MMA
#undef PG8_WAIT_V
#undef PG8_WAIT_L
#undef PG8_BAR
#undef PG8_SCHED
}
}

constexpr int NWAVES = 8, NTHREADS = 512;
constexpr int BATCH = 32, SEQ = 2048, D = 1024, FF = 2816, NGU = 2 * FF, INW = 2048, M = BATCH * SEQ;
constexpr int NPHASE = 8;
#define MK_SANITIZE 0
#ifndef MK_REPEAT_MASK
#define MK_REPEAT_MASK 0
#endif
#define REP(k) for (int rep_ = 0; rep_ <= ((MK_REPEAT_MASK >> (k)) & 1); ++rep_)
#define MK_SKIP_MASK 0
#define MK_NO_RET 0
#define MK_NO_POOL 0
#define MK_POOL_FROM_XB 0
#ifndef MK_N_LAUNCHES
#define MK_N_LAUNCHES 1
#endif
constexpr size_t MiB = 1u << 20;
constexpr size_t WS_XB = 0;
constexpr size_t WS_BIG = 128 * MiB;
constexpr size_t WS_Q = WS_BIG, WS_K = WS_Q + 32 * MiB, WS_V = WS_K + 32 * MiB, WS_SG = WS_V + 64 * MiB, WS_U = WS_SG + 64 * MiB, WS_RS = WS_U + 64 * MiB;
constexpr size_t WS_W = 512 * MiB;
constexpr size_t WS_WGU1 = WS_W, WS_WD1 = WS_WGU1 + (size_t)NGU * D * 2, WS_WGU2 = WS_WD1 + (size_t)D * FF * 2, WS_WD2 = WS_WGU2 + (size_t)NGU * D * 2;
constexpr size_t WS_WIN = WS_WD2 + (size_t)D * FF * 2, WS_WOUT = WS_WIN + (size_t)INW * D * 2, WS_WP = WS_WOUT + (size_t)D * D * 2;
constexpr size_t WS_SSQ = 576 * MiB;
constexpr size_t WS_ROPEC = 584 * MiB, WS_ROPES = WS_ROPEC + 2048 * 32 * 4;
constexpr size_t WS_CTL = 592 * MiB, CTL_BYTES = 131072, CTL_CNT = 65536;
constexpr size_t WS_XBUF = 593 * MiB;
constexpr size_t WS_END = 595 * MiB;
static_assert(WS_K == WS_Q + 32 * MiB && WS_SG == WS_V + 64 * MiB && WS_U == WS_V + 128 * MiB, "EpiWin pointer arithmetic");
static_assert(WS_RS + (size_t)M * D * 2 <= WS_W && WS_BIG + (size_t)M * FF * 2 <= WS_W && WS_WP + 4 * 128 * 128 * 2 <= WS_SSQ, "d_ws map");
constexpr int LDS_BYTES = 147456, LDS_BARST = 147456 - 64;

#define LAS __attribute__((address_space(3)))
typedef unsigned short bf16;
typedef unsigned v4u __attribute__((ext_vector_type(4)));
typedef unsigned v2u __attribute__((ext_vector_type(2)));
typedef float f32x4 __attribute__((ext_vector_type(4)));
typedef short bf16x8 __attribute__((ext_vector_type(8)));
#define LBAR() do { asm volatile("s_waitcnt lgkmcnt(0)" ::: "memory"); __builtin_amdgcn_s_barrier(); asm volatile("" ::: "memory"); } while (0)
__device__ __forceinline__ unsigned f2bf(float f) { return (unsigned)__builtin_bit_cast(unsigned short, (__bf16)f); }
__device__ __forceinline__ unsigned pk2(float lo, float hi) { return pg8::cvt_pk_bf16(lo, hi); }
__device__ __forceinline__ float bflo(unsigned w) { return __builtin_bit_cast(float, w << 16); }
__device__ __forceinline__ float bfhi(unsigned w) { return __builtin_bit_cast(float, w & 0xffff0000u); }
__device__ __forceinline__ float bf2f(unsigned short h) { return __builtin_bit_cast(float, (unsigned)h << 16); }
__device__ __forceinline__ float wave_sum(float v) {
#pragma unroll
    for (int o = 1; o < 64; o <<= 1) v += __shfl_xor(v, o);
    return v;
}
__device__ __forceinline__ f32x4 mfma16(bf16x8 a, bf16x8 b, f32x4 c) { return __builtin_amdgcn_mfma_f32_16x16x32_bf16(a, b, c, 0, 0, 0); }

__device__ const float ROPE_FREQ[32] = {
    1.000000000e+00f, 7.498942614e-01f, 5.623413324e-01f, 4.216965139e-01f, 3.162277639e-01f, 2.371373773e-01f, 1.778279394e-01f, 1.333521307e-01f,
    1.000000015e-01f, 7.498941571e-02f, 5.623413250e-02f, 4.216965288e-02f, 3.162277490e-02f, 2.371373773e-02f, 1.778279431e-02f, 1.333521493e-02f,
    9.999999776e-03f, 7.498941850e-03f, 5.623413250e-03f, 4.216964822e-03f, 3.162277630e-03f, 2.371373586e-03f, 1.778279431e-03f, 1.333521446e-03f,
    1.000000047e-03f, 7.498942432e-04f, 5.623413017e-04f, 4.216965172e-04f, 3.162277571e-04f, 2.371373703e-04f, 1.778279402e-04f, 1.333521504e-04f};

#define RLX_AGENT __ATOMIC_RELAXED, __HIP_MEMORY_SCOPE_AGENT
#define XB_TMO      128
#define XB_XCNT(j)  (256  + 64 * (j))
#define XB_XSUB(j)  (1280 + 64 * (j))
#define XB_XGEN(j)  (2304 + 64 * (j))
#define XB_TOP      3328
#define XB_TOPGEN   3392
#define XCD_BAR_WORDS 3456
#define XB_SPIN_CAP (1u << 18)

__device__ __forceinline__ unsigned xb_ld(unsigned* p)              { return __hip_atomic_load(p, __ATOMIC_RELAXED, __HIP_MEMORY_SCOPE_AGENT); }
__device__ __forceinline__ unsigned xb_add(unsigned* p, unsigned v) { return __hip_atomic_fetch_add(p, v, __ATOMIC_RELAXED, __HIP_MEMORY_SCOPE_AGENT); }
__device__ __forceinline__ unsigned xb_xcc_id() { return (unsigned)__builtin_amdgcn_s_getreg((3 << 11) | 20) & 0xFu; }
#define XB_SPIN(cond, bar) do { unsigned _sp = 0; while (cond) { __builtin_amdgcn_s_sleep(1); \
    if ((++_sp & 255u) == 0u) { if (xb_ld(&(bar)[XB_TMO])) break; if (_sp > XB_SPIN_CAP) { atomicAdd(&(bar)[XB_TMO], 1u); break; } } } } while (0)

struct XcdBarrier {
    unsigned* bar; unsigned x;
    volatile LAS unsigned* st;
};

__device__ __forceinline__ XcdBarrier xcd_barrier_post(unsigned* bar, volatile LAS unsigned* st) {
    XcdBarrier b; b.bar = bar; b.x = xb_xcc_id(); b.st = st;
    if (threadIdx.x == 0) (void)xb_add(&bar[XB_XCNT(b.x)], 1u);
    return b;
}
__device__ __forceinline__ void xcd_barrier_complete(unsigned* bar, unsigned x, unsigned& nloc, unsigned& nx) {
    const unsigned G = gridDim.x * gridDim.y * gridDim.z;
    unsigned sum, cnt, mine, sp = 0u;
    for (;;) {
        sum = 0u; cnt = 0u; mine = 0u;
#pragma unroll
        for (unsigned j = 0; j < 16; ++j) { const unsigned c = xb_ld(&bar[XB_XCNT(j)]); sum += c; cnt += (c > 0u) ? 1u : 0u; mine = (j == x) ? c : mine; }
        if (sum == G) break;
        __builtin_amdgcn_s_sleep(1);
        if ((++sp & 255u) == 0u) { if (xb_ld(&bar[XB_TMO])) break; if (sp > XB_SPIN_CAP) { atomicAdd(&bar[XB_TMO], 1u); break; } }
    }
    nloc = mine > 0u ? mine : 1u; nx = cnt > 0u ? cnt : 1u;
}

__device__ __forceinline__ void xcd_barrier(const XcdBarrier& b) {
    asm volatile("s_waitcnt vmcnt(0)" ::: "memory");
    __syncthreads();
    if (threadIdx.x == 0) {
        unsigned* bar = b.bar;
        __builtin_amdgcn_s_waitcnt(0);
        unsigned nloc = b.st[0], nx = b.st[1];
        if (nloc == 0u) { xcd_barrier_complete(bar, b.x, nloc, nx); b.st[0] = nloc; b.st[1] = nx; }
        const unsigned old = xb_add(&bar[XB_XSUB(b.x)], 1u);
        const unsigned gen = old / nloc;
        if (old + 1u == (gen + 1u) * nloc) {
            __builtin_amdgcn_fence(__ATOMIC_RELEASE, "agent");
            asm volatile("s_waitcnt vmcnt(0)" ::: "memory");
            const unsigned og = xb_add(&bar[XB_TOP], 1u);
            const unsigned tg = og / nx;
            if (og + 1u == (tg + 1u) * nx) xb_add(&bar[XB_TOPGEN], 1u);
            else XB_SPIN(xb_ld(&bar[XB_TOPGEN]) == tg, bar);
            __builtin_amdgcn_fence(__ATOMIC_ACQUIRE, "agent");
            xb_add(&bar[XB_XGEN(b.x)], 1u);
            asm volatile("s_waitcnt vmcnt(0)" ::: "memory");
        } else {
            XB_SPIN(xb_ld(&bar[XB_XGEN(b.x)]) == gen, bar);
            __builtin_amdgcn_fence(__ATOMIC_ACQUIRE, "agent");
            asm volatile("s_waitcnt vmcnt(0)" ::: "memory");
        }
    }
    __syncthreads();
}

__device__ __forceinline__ int wrow(int kind, int n) {
    if (kind == 0) return n;
    if (kind == 1) return 256 * (n >> 7) + (n & 127);
    if (kind == 2) return 256 * (n >> 7) + 128 + (n & 127);
    if (n >= 512) return n;
    const int base = n & ~255, o = n & 255, head = o >> 6, r = o & 63, nn = r >> 5, i = r & 31;
    const int bj = head >> 1, wc = 2 * (head & 1) + (i >> 4), fq = (i & 15) >> 2, e = i & 3;
    return base + 128 * bj + 32 * wc + 8 * fq + 4 * nn + e;
}
__device__ __forceinline__ void p0_transpose_item(const float* W, int K, int N, bf16* WT, int kind, const float* gain, LAS float* scr, int item, int lane) {
    const int nblk = N / 32, kb = item / nblk, nb = item % nblk, k0 = 64 * kb, n0 = 32 * nb;
    float wv[32];
#pragma unroll
    for (int i = 0; i < 32; ++i) wv[i] = W[(size_t)(k0 + 2 * i + (lane >> 5)) * N + n0 + (lane & 31)];
    if (gain) {
#pragma unroll
        for (int i = 0; i < 32; ++i) wv[i] *= gain[k0 + 2 * i + (lane >> 5)];
    }
#pragma unroll
    for (int i = 0; i < 32; ++i) scr[(2 * i + (lane >> 5)) * 33 + (lane & 31)] = wv[i];
    asm volatile("s_waitcnt lgkmcnt(0)" ::: "memory");
    const int c = lane & 7;
#pragma unroll
    for (int j = 0; j < 4; ++j) { const int n = (lane >> 3) + 8 * j; const LAS float* s = scr + (8 * c) * 33 + n;
        v4u o; o.x = pk2(s[0 * 33], s[1 * 33]); o.y = pk2(s[2 * 33], s[3 * 33]); o.z = pk2(s[4 * 33], s[5 * 33]); o.w = pk2(s[6 * 33], s[7 * 33]);
        *(v4u*)(WT + (size_t)wrow(kind, n0 + n) * K + k0 + 8 * c) = o; }
    asm volatile("s_waitcnt lgkmcnt(0)" ::: "memory");
}

struct Ptrs {
    const float *x, *n1, *g1, *u1, *d1, *nm, *win, *gng, *pw, *ps, *wout, *n2, *g2, *u2, *d2, *nf;
    float* out;
    bf16 *XB, *ACT, *Q, *K, *V, *SG, *U, *RS, *WGU1, *WD1, *WGU2, *WD2, *WIN, *WOUT, *WP;
    float *SSQ, *ROPEC, *ROPES;
};

__device__ __forceinline__ void p0_prologue(const Ptrs& P, LAS unsigned char* lds, int tid, int lane, int wave) {
    LAS float* scr = (LAS float*)(lds + wave * 16384);
    const int gw = blockIdx.x * NWAVES + wave, NGW = gridDim.x * NWAVES;
    constexpr int I_GU = (D / 64) * (FF / 32), I_DN = (FF / 64) * (D / 32), I_IN = (D / 64) * (INW / 32), I_OUT = (D / 64) * (D / 32);
    constexpr int NITEMS = 4 * I_GU + 2 * I_DN + I_IN + I_OUT;
    for (int it = gw; it < NITEMS; it += NGW) {
        int r = it;
        if (r < I_GU) { p0_transpose_item(P.g1, D, FF, P.WGU1, 1, P.n1, scr, r, lane); continue; } r -= I_GU;
        if (r < I_GU) { p0_transpose_item(P.u1, D, FF, P.WGU1, 2, P.n1, scr, r, lane); continue; } r -= I_GU;
        if (r < I_DN) { p0_transpose_item(P.d1, FF, D, P.WD1, 0, nullptr, scr, r, lane); continue; } r -= I_DN;
        if (r < I_GU) { p0_transpose_item(P.g2, D, FF, P.WGU2, 1, P.n2, scr, r, lane); continue; } r -= I_GU;
        if (r < I_GU) { p0_transpose_item(P.u2, D, FF, P.WGU2, 2, P.n2, scr, r, lane); continue; } r -= I_GU;
        if (r < I_DN) { p0_transpose_item(P.d2, FF, D, P.WD2, 0, nullptr, scr, r, lane); continue; } r -= I_DN;
        if (r < I_IN) { p0_transpose_item(P.win, D, INW, P.WIN, 3, P.nm, scr, r, lane); continue; } r -= I_IN;
        p0_transpose_item(P.wout, D, D, P.WOUT, 0, nullptr, scr, r, lane);
    }
    const int gt = blockIdx.x * NTHREADS + tid, NGT = gridDim.x * NTHREADS;
    for (int i = gt; i < 4 * 128 * 128; i += NGT) { const int g = i >> 14, d = (i >> 7) & 127, c = i & 127; P.WP[i] = (bf16)f2bf(P.pw[(g * 128 + c) * 128 + d] * P.ps[g * 128 + d]); }
    for (int i = gt; i < 2048 * 32; i += NGT) { const int pos = i >> 5; const float ang = (float)pos * ROPE_FREQ[i & 31];
        double rev = (double)ang * 0.15915494309189535; rev -= __builtin_floor(rev); const float rf = (float)rev;
        P.ROPEC[i] = __builtin_amdgcn_cosf(rf); P.ROPES[i] = __builtin_amdgcn_sinf(rf); }
    for (int m = 2 * gw; m < M; m += 2 * NGW) {
        const f32x4* xr = (const f32x4*)(P.x + (size_t)m * D) + lane; f32x4 v[2][4]; float s[2] = {0.f, 0.f};
#pragma unroll
        for (int r = 0; r < 2; ++r)
#pragma unroll
            for (int j = 0; j < 4; ++j) v[r][j] = xr[r * (D / 4) + 64 * j];
#pragma unroll
        for (int r = 0; r < 2; ++r) {
#pragma unroll
            for (int j = 0; j < 4; ++j) s[r] += (v[r][j][0] * v[r][j][0] + v[r][j][1] * v[r][j][1]) + (v[r][j][2] * v[r][j][2] + v[r][j][3] * v[r][j][3]);
            s[r] = wave_sum(s[r]);
            v2u* o8 = (v2u*)(P.XB + (size_t)(m + r) * D) + lane;
#pragma unroll
            for (int j = 0; j < 4; ++j) { v2u w; w.x = pk2(v[r][j][0], v[r][j][1]); w.y = pk2(v[r][j][2], v[r][j][3]); o8[64 * j] = w; }
            if (lane < 16) P.SSQ[(size_t)(m + r) * 16 + lane] = lane == 0 ? s[r] : 0.f;
        }
    }
}

namespace mix {
constexpr int S72 = 72, S136 = 136, S144 = 144;
constexpr int OFF_Q = 0, OFF_K = 9216, OFF_K2 = 18432, OFF_V = 27648, OFF_S = 46080, OFF_ST = 55296, OFF_SG = 73728, OFF_O = 91136, OFF_PART = 108544, OFF_STAT = 124928;
__device__ const float LG2[4] = {-0.04580368961312479f, -0.02272007650008353f, -0.011315313227834146f, -0.005646563141142063f};
__device__ __forceinline__ float ex2(float x) { return __builtin_amdgcn_exp2f(x); }
typedef short s16x4 __attribute__((ext_vector_type(4)));
__device__ __forceinline__ bf16x8 tr_frag(LAS unsigned char* img, int pitch, int c, int ks, int fq, int fr) {
    LAS unsigned char* a0 = img + (32 * ks + 8 * fq + (fr >> 2)) * pitch + 32 * c + 8 * (fr & 3);
    const s16x4 lo = __builtin_amdgcn_ds_read_tr16_b64_v4i16((LAS s16x4*)a0), hi = __builtin_amdgcn_ds_read_tr16_b64_v4i16((LAS s16x4*)(a0 + 4 * pitch));
    return __builtin_shufflevector(lo, hi, 0, 1, 2, 3, 4, 5, 6, 7);
}

constexpr int RSET = 46080, ROFF_Q = 0, ROFF_K = 9216, ROFF_K2 = 18432, ROFF_V = 27648, ROFF_S = 92160, ROFF_ST = 101376, ROFF_PART = 119808, ROFF_STAT = 136192;
__device__ __forceinline__ void retention_unit(LAS unsigned char* lds, const Ptrs& P, int b, int h, int tid) {
    const int lane = tid & 63, w = __builtin_amdgcn_readfirstlane(tid >> 6), fr = lane & 15, fq = lane >> 4;
    const float lg = LG2[h];
    LAS bf16* Ss = (LAS bf16*)(lds + ROFF_S); LAS bf16* St = (LAS bf16*)(lds + ROFF_ST);
    LAS float* part = (LAS float*)(lds + ROFF_PART); LAS float* stat = (LAS float*)(lds + ROFF_STAT);
    for (int i = tid; i < 128 * S72 * 2 / 16; i += NTHREADS) ((LAS v4u*)St)[i] = (v4u){0u, 0u, 0u, 0u};
    f32x4 st[4];
#pragma unroll
    for (int i = 0; i < 4; ++i) st[i] = (f32x4){0.f, 0.f, 0.f, 0.f};
    const int lrow = tid >> 3, lseg = tid & 7, vrow0 = tid >> 4, vseg = tid & 15;
    const size_t tok0 = (size_t)b * SEQ;
    const bf16* gq = P.Q + (tok0 + lrow) * 256 + h * 64 + lseg * 8; const bf16* gk = P.K + (tok0 + lrow) * 256 + h * 64 + lseg * 8;
    const bf16* gv = P.V + (tok0 + vrow0) * 512 + h * 128 + vseg * 8;
    const bf16* gsl = P.SG + (tok0 + fr) * 512 + h * 128 + 16 * w + 4 * fq;
    bf16* gol = P.RS + (tok0 + fr) * 1024 + h * 128 + 16 * w + 4 * fq;
    v4u rq = *(const v4u*)gq, rk = *(const v4u*)gk, rv0 = *(const v4u*)gv, rv1 = *(const v4u*)(gv + 32 * 512);
    const float dkey = ex2((float)(63 - lrow) * lg), dch = ex2(64.f * lg);
    const f32x4 gng4 = *(const f32x4*)(P.gng + h * 128 + 16 * w + 4 * fq);
    const int it3 = w >> 1;
    float dqv[4]; f32x4 decv[2];
#pragma unroll
    for (int it = 0; it < 4; ++it) dqv[it] = ex2((float)(16 * it + fr + 1) * lg);
#pragma unroll
    for (int j2 = 0; j2 < 2; ++j2)
#pragma unroll
        for (int r = 0; r < 4; ++r) decv[j2][r] = ex2(__builtin_fabsf((float)((16 * it3 + fr) - (16 * ((w & 1) * 2 + j2) + 4 * fq + r))) * lg);
    f32x4 op[4]; v2u sgr[4];
#pragma unroll
    for (int it = 0; it < 4; ++it) { op[it] = (f32x4){0.f, 0.f, 0.f, 0.f}; sgr[it] = (v2u){0u, 0u}; }
    for (int n = 0; n <= 32; ++n) {
        LAS unsigned char* bufc = lds + (n & 1) * RSET;
        LAS bf16* Qs = (LAS bf16*)(bufc + ROFF_Q); LAS bf16* Ks = (LAS bf16*)(bufc + ROFF_K); LAS bf16* K2s = (LAS bf16*)(bufc + ROFF_K2); LAS bf16* Vs = (LAS bf16*)(bufc + ROFF_V);
        if (n < 32) {
            *(LAS v4u*)(Qs + lrow * S72 + lseg * 8) = rq; *(LAS v4u*)(Ks + lrow * S72 + lseg * 8) = rk;
            v4u k2;
#pragma unroll
            for (int t = 0; t < 4; ++t) k2[t] = pk2(bflo(rk[t]) * dkey, bfhi(rk[t]) * dkey);
            *(LAS v4u*)(K2s + lrow * S72 + lseg * 8) = k2;
            *(LAS v4u*)(Vs + vrow0 * S144 + vseg * 8) = rv0; *(LAS v4u*)(Vs + (vrow0 + 32) * S144 + vseg * 8) = rv1;
        }
        if (n >= 1) {
#pragma unroll
            for (int it = 0; it < 4; ++it) sgr[it] = *(const v2u*)(gsl + ((size_t)(n - 1) * 64 + 16 * it) * 512);
        }
        LBAR();
        if (n + 1 < 32) { const size_t o4 = (size_t)(n + 1) * 64;
            rq = *(const v4u*)(gq + o4 * 256); rk = *(const v4u*)(gk + o4 * 256); rv0 = *(const v4u*)(gv + o4 * 512); rv1 = *(const v4u*)(gv + (o4 + 32) * 512); }
        if (n >= 1) {
            const int row = tid >> 3, sub = tid & 7;
            const f32x4 pa = *(const LAS f32x4*)(part + (row * 32 + sub * 4) * 2), pb = *(const LAS f32x4*)(part + (row * 32 + sub * 4) * 2 + 4);
            float s1 = (pa[0] + pa[2]) + (pb[0] + pb[2]), s2 = (pa[1] + pa[3]) + (pb[1] + pb[3]);
#pragma unroll
            for (int x = 1; x < 8; x <<= 1) { s1 += __shfl_xor(s1, x); s2 += __shfl_xor(s2, x); }
            if (sub == 0) { const float mean = s1 * (1.f / 128.f); float var = s2 * (1.f / 128.f) - mean * mean; var = var < 0.f ? 0.f : var;
                stat[row * 2] = mean; stat[row * 2 + 1] = __builtin_amdgcn_rsqf(var + 1e-5f); }
        }
        if (n < 32) {
#pragma unroll
            for (int j2 = 0; j2 < 2; ++j2) {
                const int jt = (w & 1) * 2 + j2; f32x4 a4 = (f32x4){0.f, 0.f, 0.f, 0.f};
#pragma unroll
                for (int ks = 0; ks < 2; ++ks) {
                    const bf16x8 qf = *(const LAS bf16x8*)(Qs + (16 * it3 + fr) * S72 + 32 * ks + 8 * fq), kf = *(const LAS bf16x8*)(Ks + (16 * jt + fr) * S72 + 32 * ks + 8 * fq);
                    a4 = mfma16(kf, qf, a4); }
                a4 = a4 * decv[j2];
                v2u pw; pw.x = pk2(a4[0], a4[1]); pw.y = pk2(a4[2], a4[3]);
                *(LAS v2u*)(Ss + (16 * it3 + fr) * S72 + 16 * jt + 4 * fq) = pw;
            }
        }
        LBAR();
        if (n >= 1) {
#pragma unroll
            for (int it = 0; it < 4; ++it) { const int i = 16 * it + fr; const float mean = stat[i * 2], rstd = stat[i * 2 + 1]; const v2u sg = sgr[it];
                const f32x4 y = (op[it] - mean) * rstd * gng4 * (f32x4){bflo(sg.x), bfhi(sg.x), bflo(sg.y), bfhi(sg.y)};
                v2u pw; pw.x = pk2(y[0], y[1]); pw.y = pk2(y[2], y[3]);
                *(v2u*)(gol + ((size_t)(n - 1) * 64 + 16 * it) * 1024) = pw; }
        }
        if (n < 32) {
            f32x4 o[4]; bf16x8 bst[2], bv[2];
#pragma unroll
            for (int ks = 0; ks < 2; ++ks) { bst[ks] = *(const LAS bf16x8*)(St + (16 * w + fr) * S72 + 32 * ks + 8 * fq); bv[ks] = tr_frag(bufc + ROFF_V, S144 * 2, w, ks, fq, fr); }
#pragma unroll
            for (int it = 0; it < 4; ++it) { o[it] = (f32x4){0.f, 0.f, 0.f, 0.f};
#pragma unroll
                for (int ks = 0; ks < 2; ++ks) { const bf16x8 qf = *(const LAS bf16x8*)(Qs + (16 * it + fr) * S72 + 32 * ks + 8 * fq); o[it] = mfma16(bst[ks], qf, o[it]); }
                o[it] = o[it] * dqv[it];
#pragma unroll
                for (int ks = 0; ks < 2; ++ks) { const bf16x8 sf = *(const LAS bf16x8*)(Ss + (16 * it + fr) * S72 + 32 * ks + 8 * fq); o[it] = mfma16(bv[ks], sf, o[it]); }
            }
#pragma unroll
            for (int dt = 0; dt < 4; ++dt) { st[dt] = st[dt] * dch;
#pragma unroll
                for (int ks = 0; ks < 2; ++ks) { const bf16x8 kf = tr_frag(bufc + ROFF_K2, S72 * 2, dt, ks, fq, fr); st[dt] = mfma16(kf, bv[ks], st[dt]); }
                v2u pw; pw.x = pk2(st[dt][0], st[dt][1]); pw.y = pk2(st[dt][2], st[dt][3]);
                *(LAS v2u*)(St + (16 * w + fr) * S72 + 16 * dt + 4 * fq) = pw; }
#pragma unroll
            for (int it = 0; it < 4; ++it) { const f32x4 v = o[it]; typedef float f32x2 __attribute__((ext_vector_type(2)));
                *(LAS f32x2*)(part + ((16 * it + fr) * 32 + w * 4 + fq) * 2) = (f32x2){(v[0] + v[1]) + (v[2] + v[3]), (v[0] * v[0] + v[1] * v[1]) + (v[2] * v[2] + v[3] * v[3])};
                op[it] = v; }
        }
    }
    LBAR();
}

constexpr int POOL_US = 0, POOL_PS = 21504, POOL_YS = POOL_PS + 64 * S136 * 2;
#define POOL_LOAD(tile_) do { _Pragma("unroll") for (int k_ = 0; k_ < 3; ++k_) { const int idx_ = tid + 512 * k_, r_ = idx_ >> 4; \
        const bool ok_ = (idx_ < 79 * 16) && ((((tile_) & 31) != 0) || r_ >= 15); const long grow_ = (long)(tile_) * 64 - 15 + r_; \
        pf[k_] = ok_ ? *(const v4u*)(P.U + (size_t)grow_ * 512 + g * 128 + vseg * 8) : (v4u){0u, 0u, 0u, 0u}; } } while (0)
template <int WIN>
__device__ __forceinline__ void pool_block_t(LAS unsigned char* lds, const Ptrs& P, int g, int tile0, int tstep, int tid) {
    const int lane = tid & 63, w = __builtin_amdgcn_readfirstlane(tid >> 6), fr = lane & 15, fq = lane >> 4;
    LAS bf16* Us = (LAS bf16*)(lds + POOL_US); LAS bf16* Ps = (LAS bf16*)(lds + POOL_PS); LAS bf16* Ys = (LAS bf16*)(lds + POOL_YS);
    bf16x8 bw[4];
#pragma unroll
    for (int ks = 0; ks < 4; ++ks) bw[ks] = *(const bf16x8*)(P.WP + (size_t)(g * 128 + 16 * w + fr) * 128 + 32 * ks + 8 * fq);
    const int vrow0 = tid >> 4, vseg = tid & 15;
    v4u pf[3];
    POOL_LOAD(tile0);
    for (int tile = tile0; tile < M / 64; tile += tstep) {
#pragma unroll
        for (int k = 0; k < 3; ++k) { const int idx = tid + 512 * k; if (idx < 79 * 16) *(LAS v4u*)(Us + (idx >> 4) * S136 + vseg * 8) = pf[k]; }
        LBAR();
        if (tile + tstep < M / 64) POOL_LOAD(tile + tstep);
#pragma unroll
        for (int rep = 0; rep < 2; ++rep) {
            const int row = vrow0 + 32 * rep; const int pos = (tile * 64 + row) & 2047; const int cnt = (pos + 1 < WIN) ? pos + 1 : WIN;
            const v4u cur = *(const LAS v4u*)(Us + (row + 15) * S136 + vseg * 8); float a[8];
#pragma unroll
            for (int k = 0; k < 4; ++k) { a[2 * k] = bflo(cur[k]); a[2 * k + 1] = bfhi(cur[k]); }
#pragma unroll
            for (int tau = 1; tau < WIN; ++tau) { const v4u v = *(const LAS v4u*)(Us + (row + 15 - tau) * S136 + vseg * 8);
#pragma unroll
                for (int k = 0; k < 4; ++k) { a[2 * k] += bflo(v[k]); a[2 * k + 1] += bfhi(v[k]); } }
            const float inv = __builtin_amdgcn_rcpf((float)cnt); v4u o;
#pragma unroll
            for (int k = 0; k < 4; ++k) o[k] = pk2(a[2 * k] * inv - bflo(cur[k]), a[2 * k + 1] * inv - bfhi(cur[k]));
            *(LAS v4u*)(Ps + row * S136 + vseg * 8) = o;
        }
        LBAR();
#pragma unroll
        for (int it = 0; it < 4; ++it) { f32x4 acc = (f32x4){0.f, 0.f, 0.f, 0.f};
#pragma unroll
            for (int ks = 0; ks < 4; ++ks) { const bf16x8 a = *(const LAS bf16x8*)(Ps + (16 * it + fr) * S136 + 32 * ks + 8 * fq); acc = mfma16(bw[ks], a, acc); }
            v2u pw; pw.x = pk2(acc[0], acc[1]); pw.y = pk2(acc[2], acc[3]);
            *(LAS v2u*)(Ys + (16 * it + fr) * S136 + 16 * w + 4 * fq) = pw; }
        LBAR();
#pragma unroll
        for (int rep = 0; rep < 2; ++rep) { const int row = vrow0 + 32 * rep; const size_t t = (size_t)tile * 64 + row;
            *(v4u*)(P.RS + t * 1024 + 512 + g * 128 + vseg * 8) = *(const LAS v4u*)(Ys + row * S136 + vseg * 8); }
    }
    LBAR();
}
__device__ __forceinline__ void pool_block(LAS unsigned char* lds, const Ptrs& P, int pblk, int npblk, int tid) {
    const int g = pblk & 3, tile0 = pblk >> 2, tstep = npblk >> 2;
    if (g == 0) pool_block_t<2>(lds, P, g, tile0, tstep, tid);
    else if (g == 1) pool_block_t<4>(lds, P, g, tile0, tstep, tid);
    else if (g == 2) pool_block_t<8>(lds, P, g, tile0, tstep, tid);
    else pool_block_t<16>(lds, P, g, tile0, tstep, tid);
}
}

struct Args { const float* in[16]; float* out; unsigned char* ws; int ph_lo, ph_hi; };
__global__ void __launch_bounds__(NTHREADS, 2) mk_fwd(Args args) {
    extern __shared__ __attribute__((aligned(16))) unsigned char lds_raw[];
    LAS unsigned char* lds = (LAS unsigned char*)lds_raw;
    const int tid = threadIdx.x, lane = tid & 63, wave = __builtin_amdgcn_readfirstlane(tid >> 6);
    const int G = gridDim.x;
    unsigned char* ws = args.ws;
    Ptrs P;
    P.x = args.in[0]; P.n1 = args.in[1]; P.g1 = args.in[2]; P.u1 = args.in[3]; P.d1 = args.in[4]; P.nm = args.in[5]; P.win = args.in[6]; P.gng = args.in[7];
    P.pw = args.in[8]; P.ps = args.in[9]; P.wout = args.in[10]; P.n2 = args.in[11]; P.g2 = args.in[12]; P.u2 = args.in[13]; P.d2 = args.in[14]; P.nf = args.in[15];
    P.out = args.out;
    P.XB = (bf16*)(ws + WS_XB); P.ACT = (bf16*)(ws + WS_BIG); P.Q = (bf16*)(ws + WS_Q); P.K = (bf16*)(ws + WS_K); P.V = (bf16*)(ws + WS_V); P.SG = (bf16*)(ws + WS_SG);
    P.U = (bf16*)(ws + WS_U); P.RS = (bf16*)(ws + WS_RS);
    P.WGU1 = (bf16*)(ws + WS_WGU1); P.WD1 = (bf16*)(ws + WS_WD1); P.WGU2 = (bf16*)(ws + WS_WGU2); P.WD2 = (bf16*)(ws + WS_WD2); P.WIN = (bf16*)(ws + WS_WIN);
    P.WOUT = (bf16*)(ws + WS_WOUT); P.WP = (bf16*)(ws + WS_WP);
    P.SSQ = (float*)(ws + WS_SSQ); P.ROPEC = (float*)(ws + WS_ROPEC); P.ROPES = (float*)(ws + WS_ROPES);
    const int lo = args.ph_lo, hi = args.ph_hi;
    if (tid < 16) ((LAS unsigned*)(lds + LDS_BARST))[tid] = 0u;
    __syncthreads();
    XcdBarrier xbar; xbar.bar = (unsigned*)(ws + WS_CTL); xbar.x = 0; xbar.st = nullptr;
    if (hi - lo > 1) xbar = xcd_barrier_post((unsigned*)(ws + WS_CTL), (volatile LAS unsigned*)(lds + LDS_BARST));
#define IN(k) (lo <= (k) && (k) < hi)
#define SEAM(k) do { if (IN(k) && IN((k) + 1)) { xcd_barrier(xbar); } } while (0)

    if (lo < 0) cg::this_grid().sync();
    if (IN(0)) { REP(0) p0_prologue(P, lds, tid, lane, wave); SEAM(0); }
    if (IN(1)) {
        pg8::Gemm g{P.XB, P.WGU1, M, NGU, D}; pg8::StaticOrder S; S.init(M, NGU, G, (int)blockIdx.x);
        pg8::EpiSwiGLU E{P.ACT, P.SSQ};
        REP(1) pg8::gemm_phase<pg8::EpiSwiGLU, pg8::StaticOrder, true, true>(lds, g, S, E);
        SEAM(1);
    }
    if (IN(2)) {
        pg8::Gemm g{P.ACT, P.WD1, M, D, FF}; pg8::StaticOrder S; S.init(M, D, G, (int)blockIdx.x);
        pg8::EpiResid E{P.XB, P.XB, P.SSQ, 0.5f};
        REP(2) pg8::gemm_phase<pg8::EpiResid, pg8::StaticOrder, true, true, true>(lds, g, S, E);
        SEAM(2);
    }
    if (IN(3)) {
        pg8::Gemm g{P.XB, P.WIN, M, INW, D}; pg8::StaticOrder S; S.init(M, INW, G, (int)blockIdx.x);
        pg8::EpiWin E{P.Q, P.V, P.SSQ, P.ROPEC, P.ROPES};
        REP(3) pg8::gemm_phase<pg8::EpiWin, pg8::StaticOrder, true, true>(lds, g, S, E);
        SEAM(3);
    }
    if (IN(4)) {
        const int bx = blockIdx.x;
        REP(4)
        if (G >= 8) {
            const int npool = (G / 2) & ~3, nret = G - npool;
            if (bx < nret) {
#if MK_NO_RET
                for (size_t i = (size_t)bx * NTHREADS + tid; i < (size_t)M * 64; i += (size_t)nret * NTHREADS) *(v4u*)(P.RS + (i >> 6) * 1024 + (i & 63) * 8) = (v4u){0u, 0u, 0u, 0u};
#else
                for (int u = bx; u < BATCH * 4; u += nret) mix::retention_unit(lds, P, u >> 2, u & 3, tid);
#endif
            } else {
#if MK_NO_POOL
                for (size_t i = (size_t)(bx - nret) * NTHREADS + tid; i < (size_t)M * 64; i += (size_t)npool * NTHREADS) *(v4u*)(P.RS + (i >> 6) * 1024 + 512 + (i & 63) * 8) = (v4u){0u, 0u, 0u, 0u};
#else
                mix::pool_block(lds, P, bx - nret, npool, tid);
#endif
            }
        } else {
            for (int u = bx; u < BATCH * 4; u += G) mix::retention_unit(lds, P, u >> 2, u & 3, tid);
            for (int pb = bx; pb < 4 * G; pb += G) mix::pool_block(lds, P, pb, 4 * G, tid);
        }
        SEAM(4);
    }
    if (IN(5)) {
        pg8::Gemm g{P.RS, P.WOUT, M, D, D}; pg8::StaticOrder S; S.init(M, D, G, (int)blockIdx.x);
        pg8::EpiResid E{P.XB, P.XB, P.SSQ, 1.0f};
        pg8::gemm_phase<pg8::EpiResid, pg8::StaticOrder, true, true>(lds, g, S, E);
        SEAM(5);
    }
    if (IN(6)) {
        pg8::Gemm g{P.XB, P.WGU2, M, NGU, D}; pg8::StaticOrder S; S.init(M, NGU, G, (int)blockIdx.x);
        pg8::EpiSwiGLU E{P.ACT, P.SSQ};
        REP(6) pg8::gemm_phase<pg8::EpiSwiGLU, pg8::StaticOrder, true, true>(lds, g, S, E);
        SEAM(6);
    }
    if (IN(7)) {
        pg8::Gemm g{P.ACT, P.WD2, M, D, FF}; pg8::StaticOrder S; S.init(M, D, G, (int)blockIdx.x);
        pg8::EpiFinalNorm E{P.XB, P.out, P.nf, (unsigned*)(ws + WS_XBUF), (unsigned*)(ws + WS_CTL + CTL_CNT), lds + pg8::STAGE_BYTES, 0.5f};
        pg8::gemm_phase<pg8::EpiFinalNorm, pg8::StaticOrder, true, true, true>(lds, g, S, E);
    }
#undef IN
#undef SEAM
}

extern "C" void kernel_launch(void* const* d_in, const int* in_sizes, int n_in, void* d_out, int out_size, void* d_ws, size_t ws_size, hipStream_t stream) {
    static int grid = 0;
    if (grid == 0) {
        if (n_in != 16 || in_sizes[0] != M * D || out_size != M * D || ws_size < WS_END) { fprintf(stderr, "kernel_launch: unexpected shapes (n_in %d, in0 %d, out %d, ws %zu); nothing launched\n", n_in, n_in > 0 ? in_sizes[0] : -1, out_size, ws_size); grid = -1; return; }
        int dev = 0, cus = 0, per_cu = 0;
        if (hipGetDevice(&dev) != hipSuccess || hipDeviceGetAttribute(&cus, hipDeviceAttributeMultiprocessorCount, dev) != hipSuccess) { grid = -1; return; }
        if (hipFuncSetAttribute((const void*)mk_fwd, hipFuncAttributeMaxDynamicSharedMemorySize, LDS_BYTES) != hipSuccess) { fprintf(stderr, "kernel_launch: hipFuncSetAttribute failed\n"); grid = -1; return; }
        if (hipOccupancyMaxActiveBlocksPerMultiprocessor(&per_cu, (const void*)mk_fwd, NTHREADS, LDS_BYTES) != hipSuccess || per_cu < 1) { fprintf(stderr, "kernel_launch: occupancy query gave %d\n", per_cu); per_cu = 1; }
        (void)hipGetLastError();
        grid = cus * per_cu;
        if (grid > 256) grid = 256;
        if (grid != 256) fprintf(stderr, "kernel_launch: note: %d co-resident workgroups (expected 256): the fused final-norm exchange assumes 256\n", grid);
    }
    if (grid < 0) return;
    Args a{};
    for (int i = 0; i < 16; ++i) a.in[i] = (const float*)d_in[i];
    a.out = (float*)d_out; a.ws = (unsigned char*)d_ws;
#if MK_N_LAUNCHES == 1
    if (hipMemsetAsync((char*)d_ws + WS_CTL, 0, CTL_BYTES, stream) != hipSuccess) { fprintf(stderr, "kernel_launch: hipMemsetAsync failed\n"); return; }
    a.ph_lo = 0; a.ph_hi = NPHASE;
    void* kargs[] = {&a};
    const hipError_t le = hipLaunchCooperativeKernel((const void*)mk_fwd, dim3(grid), dim3(NTHREADS), kargs, LDS_BYTES, stream);
    if (le != hipSuccess) fprintf(stderr, "kernel_launch: cooperative launch failed: %s (grid %d)\n", hipGetErrorString(le), grid);
#else
    for (int ph = 0; ph < NPHASE; ++ph) {
        if (MK_SKIP_MASK & (1 << ph)) continue;
        a.ph_lo = ph; a.ph_hi = ph + 1;
        hipLaunchKernelGGL(mk_fwd, dim3(grid), dim3(NTHREADS), LDS_BYTES, stream, a);
    }
#endif
}
```

```cpp
#include <hip/hip_runtime.h>
#include <hip/hip_cooperative_groups.h>
#include <cstdio>
#include <cstdint>
namespace cg = cooperative_groups;
namespace pg8 {
#define PG8_LAS __attribute__((address_space(3)))
typedef unsigned short bf16_t;
typedef short bf16x8 __attribute__((ext_vector_type(8)));
typedef float f32x4 __attribute__((ext_vector_type(4)));
typedef unsigned u32x4 __attribute__((ext_vector_type(4)));
constexpr int BM = 256, BK = 64, HALF = 128, HTB = HALF * BK * 2  , STAGE_BYTES = 8 * HTB, NXCD = 8, WGM = 8;

__host__ __device__ __forceinline__ int lds_byte(int r, int c) { const int st = (r >> 4) * 2 + (c >> 5), rr = r & 15, cc = c & 31, ob = rr * 64 + cc * 2; return st * 1024 + (ob ^ (((ob >> 9) & 1) << 5)); }
__host__ __device__ __forceinline__ void stage_rc(int b, int& R, int& C) { const int st = b / 1024, sb = b % 1024, swz = sb ^ (((sb >> 9) & 1) << 5); R = (st >> 1) * 16 + swz / 64; C = (st & 1) * 32 + (swz % 64) / 2; }
__host__ __device__ __forceinline__ int perm32(int rho) { const int n = rho >> 4, i = rho & 15; return 8 * (i >> 2) + 4 * n + (i & 3); }

struct Unit { int pm, pn; };
struct Gemm { const bf16_t* A; const bf16_t* Bt; int M, N, K; };

struct StaticOrder {
    int nM, nN, nwg, G, c;
    __host__ __device__ void init(int M, int N, int G_, int c_) { nM = M / BM; nN = N / BM; nwg = nM * nN; G = G_; c = c_; }
    __host__ __device__ bool next(int i, Unit& u) const {
        const long L = (long)i * G + c; if (L >= nwg) return false;
        int wgid = (int)L; { const int q = nwg / NXCD, r = nwg % NXCD, xcd = wgid % NXCD, off = wgid / NXCD; wgid = (xcd < r ? xcd * (q + 1) : r * (q + 1) + (xcd - r) * q) + off; }
        const int nig = WGM * nN, gid = wgid / nig, fm = gid * WGM, gsz = (nM - fm) < WGM ? (nM - fm) : WGM;
        u.pm = fm + ((wgid % nig) % gsz); u.pn = (wgid % nig) / gsz; return true;
    }
    __device__ __forceinline__ void a_ready(const Unit&) const {}
    __device__ __forceinline__ void done(const Unit&) const {}
};

typedef __bf16 bf16v2 __attribute__((ext_vector_type(2)));
__device__ __forceinline__ unsigned cvt_pk_bf16(float lo, float hi) { typedef float f2 __attribute__((ext_vector_type(2))); const bf16v2 r = __builtin_convertvector((f2){lo, hi}, bf16v2); return __builtin_bit_cast(unsigned, r); }
typedef float f32x2 __attribute__((ext_vector_type(2)));
typedef unsigned u32x2 __attribute__((ext_vector_type(2)));
constexpr int DM = 1024, DFF = 2816;
constexpr float RMS_EPS = 1e-6f;
__device__ __forceinline__ float row_rstd(const float* ssq, int row, int fq) {
    const f32x4 p = *(const f32x4*)(ssq + (size_t)row * 16 + 4 * fq);
    float s = (p[0] + p[1]) + (p[2] + p[3]);
    s += __shfl_xor(s, 16); s += __shfl_xor(s, 32);
    return __builtin_amdgcn_rsqf(s * (1.0f / (float)DM) + RMS_EPS);
}
__device__ __forceinline__ float silu_f(float x) { return x * __builtin_amdgcn_rcpf(1.0f + __builtin_amdgcn_exp2f(-1.4426950408889634f * x)); }
__device__ __forceinline__ f32x4 silu4(f32x4 v) { return (f32x4){silu_f(v[0]), silu_f(v[1]), silu_f(v[2]), silu_f(v[3])}; }

__device__ __forceinline__ void rows_rstd(const float* ssq, int row0, int fq, float (&rs)[2][4]) {
    f32x4 p[2][4];
#pragma unroll
    for (int ai = 0; ai < 2; ++ai)
#pragma unroll
        for (int m = 0; m < 4; ++m) p[ai][m] = *(const f32x4*)(ssq + (size_t)(row0 + ai * HALF + m * 16) * 16 + 4 * fq);
#pragma unroll
    for (int ai = 0; ai < 2; ++ai)
#pragma unroll
        for (int m = 0; m < 4; ++m) { float s = (p[ai][m][0] + p[ai][m][1]) + (p[ai][m][2] + p[ai][m][3]); s += __shfl_xor(s, 16); s += __shfl_xor(s, 32); rs[ai][m] = __builtin_amdgcn_rsqf(s * (1.0f / (float)DM) + RMS_EPS); }
}
struct EpiSwiGLU {
    static constexpr bool PERM = true, AFTER_DRAIN = false;
    bf16_t* O; const float* ssq;
    __device__ __forceinline__ void operator()(const f32x4 (&acc)[2][2][4][2], const Unit& u, int wr, int wc, int fr, int fq) const {
        const int row0 = u.pm * BM + wr * 64 + fr, col0 = u.pn * HALF + wc * 32 + 8 * fq;
        float rsv[2][4]; rows_rstd(ssq, row0, fq, rsv);
#pragma unroll
        for (int ai = 0; ai < 2; ++ai)
#pragma unroll
            for (int m = 0; m < 4; ++m) {
                const int row = row0 + ai * HALF + m * 16; const float rs = rsv[ai][m], cexp = -1.4426950408889634f * rs, rs2 = rs * rs;
                const f32x4 g0 = acc[ai][0][m][0], g1 = acc[ai][0][m][1], u0 = acc[ai][1][m][0], u1 = acc[ai][1][m][1];
                const f32x4 t0 = g0 * cexp, t1 = g1 * cexp;
                f32x4 d0 = (f32x4){__builtin_amdgcn_exp2f(t0[0]), __builtin_amdgcn_exp2f(t0[1]), __builtin_amdgcn_exp2f(t0[2]), __builtin_amdgcn_exp2f(t0[3])} + 1.0f;
                f32x4 d1 = (f32x4){__builtin_amdgcn_exp2f(t1[0]), __builtin_amdgcn_exp2f(t1[1]), __builtin_amdgcn_exp2f(t1[2]), __builtin_amdgcn_exp2f(t1[3])} + 1.0f;
                const f32x4 r0 = (f32x4){__builtin_amdgcn_rcpf(d0[0]), __builtin_amdgcn_rcpf(d0[1]), __builtin_amdgcn_rcpf(d0[2]), __builtin_amdgcn_rcpf(d0[3])} * rs2;
                const f32x4 r1 = (f32x4){__builtin_amdgcn_rcpf(d1[0]), __builtin_amdgcn_rcpf(d1[1]), __builtin_amdgcn_rcpf(d1[2]), __builtin_amdgcn_rcpf(d1[3])} * rs2;
                const f32x4 a0 = (g0 * u0) * r0, a1 = (g1 * u1) * r1;
                u32x4 w; w.x = cvt_pk_bf16(a0[0], a0[1]); w.y = cvt_pk_bf16(a0[2], a0[3]); w.z = cvt_pk_bf16(a1[0], a1[1]); w.w = cvt_pk_bf16(a1[2], a1[3]);
                *(u32x4*)(O + (((size_t)(row >> 8) * (DFF / BK) + (col0 >> 6)) * BM + (row & 255)) * BK + (col0 & 63)) = w;
            }
    }
};
__device__ __forceinline__ void bf8_to_f32(const u32x4 w, f32x4& lo, f32x4& hi) {
    lo = (f32x4){__builtin_bit_cast(float, w.x << 16), __builtin_bit_cast(float, w.x & 0xffff0000u), __builtin_bit_cast(float, w.y << 16), __builtin_bit_cast(float, w.y & 0xffff0000u)};
    hi = (f32x4){__builtin_bit_cast(float, w.z << 16), __builtin_bit_cast(float, w.z & 0xffff0000u), __builtin_bit_cast(float, w.w << 16), __builtin_bit_cast(float, w.w & 0xffff0000u)};
}
struct EpiResid {
    static constexpr bool PERM = true, AFTER_DRAIN = false;
    const bf16_t* base; bf16_t* xb; float* ssq; float alpha;
    __device__ __forceinline__ void operator()(const f32x4 (&acc)[2][2][4][2], const Unit& u, int wr, int wc, int fr, int fq) const {
        const int row0 = u.pm * BM + wr * 64 + fr, col0 = u.pn * BM + wc * 32 + 8 * fq;
#pragma unroll
        for (int ai = 0; ai < 2; ++ai) {
            u32x4 pre[4][2];
#pragma unroll
            for (int m = 0; m < 4; ++m)
#pragma unroll
                for (int bj = 0; bj < 2; ++bj) pre[m][bj] = *(const u32x4*)(base + (size_t)(row0 + ai * HALF + m * 16) * DM + col0 + bj * HALF);
#pragma unroll
            for (int m = 0; m < 4; ++m) {
                const int row = row0 + ai * HALF + m * 16; float q = 0.f;
#pragma unroll
                for (int bj = 0; bj < 2; ++bj) {
                    const size_t off = (size_t)row * DM + col0 + bj * HALF;
                    f32x4 b0, b1; bf8_to_f32(pre[m][bj], b0, b1);
                    const f32x4 o0 = b0 + acc[ai][bj][m][0] * alpha, o1 = b1 + acc[ai][bj][m][1] * alpha;
                    u32x4 w; w.x = cvt_pk_bf16(o0[0], o0[1]); w.y = cvt_pk_bf16(o0[2], o0[3]); w.z = cvt_pk_bf16(o1[0], o1[1]); w.w = cvt_pk_bf16(o1[2], o1[3]); *(u32x4*)(xb + off) = w;
                    q += (o0[0] * o0[0] + o0[1] * o0[1]) + (o0[2] * o0[2] + o0[3] * o0[3]) + (o1[0] * o1[0] + o1[1] * o1[1]) + (o1[2] * o1[2] + o1[3] * o1[3]);
                }
                q += __shfl_xor(q, 16); q += __shfl_xor(q, 32);
                if (fq == 0) ssq[(size_t)row * 16 + u.pn * 4 + wc] = q;
            }
        }
    }
};
struct EpiFinalNorm {
    static constexpr bool PERM = true, AFTER_DRAIN = false;
    const bf16_t* base; float* out; const float* gain; unsigned* xbuf; unsigned* cnt; PG8_LAS unsigned char* xl; float alpha;
    __device__ __forceinline__ void operator()(f32x4 (&acc)[2][2][4][2], const Unit& u, int wr, int wc, int fr, int fq) const {
        const int wid = wr * 4 + wc, lane = fq * 16 + fr;
        PG8_LAS float* Pt = (PG8_LAS float*)xl; PG8_LAS float* Sr = (PG8_LAS float*)(xl + 4096);
        const int row0 = u.pm * BM + wr * 64 + fr, col0 = u.pn * BM + wc * 32 + 8 * fq;
        f32x4 gv[2][2];
#pragma unroll
        for (int bj = 0; bj < 2; ++bj)
#pragma unroll
            for (int n = 0; n < 2; ++n) gv[bj][n] = *(const f32x4*)(gain + col0 + bj * HALF + 4 * n);
#pragma unroll
        for (int ai = 0; ai < 2; ++ai) {
            u32x4 pre[4][2];
#pragma unroll
            for (int m = 0; m < 4; ++m)
#pragma unroll
                for (int bj = 0; bj < 2; ++bj) pre[m][bj] = *(const u32x4*)(base + (size_t)(row0 + ai * HALF + m * 16) * DM + col0 + bj * HALF);
#pragma unroll
            for (int m = 0; m < 4; ++m) { float q = 0.f;
#pragma unroll
                for (int bj = 0; bj < 2; ++bj) {
                    f32x4 b0, b1; bf8_to_f32(pre[m][bj], b0, b1);
                    const f32x4 o0 = b0 + acc[ai][bj][m][0] * alpha, o1 = b1 + acc[ai][bj][m][1] * alpha;
                    acc[ai][bj][m][0] = o0; acc[ai][bj][m][1] = o1;
                    q += (o0[0] * o0[0] + o0[1] * o0[1]) + (o0[2] * o0[2] + o0[3] * o0[3]) + (o1[0] * o1[0] + o1[1] * o1[1]) + (o1[2] * o1[2] + o1[3] * o1[3]);
                }
                q += __shfl_xor(q, 16); q += __shfl_xor(q, 32);
                if (fq == 0) Pt[(ai * HALF + wr * 64 + m * 16 + fr) * 4 + wc] = q;
            }
        }
        asm volatile("s_waitcnt lgkmcnt(0)" ::: "memory"); __builtin_amdgcn_s_barrier(); asm volatile("" ::: "memory");
        const int row = wid * 32 + (lane & 31);
        if (lane < 32) { const f32x4 p = *(const PG8_LAS f32x4*)(Pt + row * 4);
            __hip_atomic_store(xbuf + (size_t)(u.pm * BM + row) * 4 + u.pn, __builtin_bit_cast(unsigned, (p[0] + p[1]) + (p[2] + p[3])), __ATOMIC_RELAXED, __HIP_MEMORY_SCOPE_AGENT); }
        asm volatile("s_waitcnt vmcnt(0)" ::: "memory");
        if (lane == 0) __hip_atomic_fetch_add(cnt + 64 * u.pm, 1u, __ATOMIC_RELAXED, __HIP_MEMORY_SCOPE_AGENT);
        if (wid == 0) {
            unsigned spins = 0u;
            while ((unsigned)__builtin_amdgcn_readfirstlane(__hip_atomic_load(cnt + 64 * u.pm, __ATOMIC_RELAXED, __HIP_MEMORY_SCOPE_AGENT)) < 32u) { __builtin_amdgcn_s_sleep(2); if (++spins > (1u << 22)) break; }
            __builtin_amdgcn_fence(__ATOMIC_ACQUIRE, "agent");
        }
        asm volatile("s_waitcnt vmcnt(0) lgkmcnt(0)" ::: "memory"); __builtin_amdgcn_s_barrier(); asm volatile("" ::: "memory");
        if (lane < 32) { const unsigned* slot = xbuf + (size_t)(u.pm * BM + row) * 4; float t = 0.f;
#pragma unroll
            for (int k = 0; k < 4; ++k) t += __builtin_bit_cast(float, __hip_atomic_load(slot + k, __ATOMIC_RELAXED, __HIP_MEMORY_SCOPE_AGENT));
            Sr[row] = __builtin_amdgcn_rsqf(t * (1.0f / (float)DM) + RMS_EPS); }
        asm volatile("s_waitcnt lgkmcnt(0)" ::: "memory"); __builtin_amdgcn_s_barrier(); asm volatile("" ::: "memory");
#pragma unroll
        for (int ai = 0; ai < 2; ++ai)
#pragma unroll
            for (int m = 0; m < 4; ++m) { const float rs = Sr[ai * HALF + wr * 64 + m * 16 + fr];
#pragma unroll
                for (int bj = 0; bj < 2; ++bj) { const size_t off = (size_t)(row0 + ai * HALF + m * 16) * DM + col0 + bj * HALF;
                    *(f32x4*)(out + off) = acc[ai][bj][m][0] * rs * gv[bj][0]; *(f32x4*)(out + off + 4) = acc[ai][bj][m][1] * rs * gv[bj][1]; } }
    }
};
struct EpiWin {
    static constexpr bool PERM = true, AFTER_DRAIN = false;
    bf16_t *Q, *V; const float* ssq; const float* ropec; const float* ropes;
    __device__ __forceinline__ void operator()(const f32x4 (&acc)[2][2][4][2], const Unit& u, int wr, int wc, int fr, int fq) const {
        const int row0 = u.pm * BM + wr * 64 + fr, pn = u.pn;
        float rsv[2][4]; rows_rstd(ssq, row0, fq, rsv);
        if (pn < 2) {
            const int i0 = 16 * (wc & 1) + 4 * fq; const float qs = pn == 0 ? 0.125f : 1.0f;
#pragma unroll
            for (int ai = 0; ai < 2; ++ai) {
                f32x4 cc[4], ss[4];
#pragma unroll
                for (int m = 0; m < 4; ++m) { const int pos = (row0 + ai * HALF + m * 16) & 2047; cc[m] = *(const f32x4*)(ropec + pos * 32 + i0); ss[m] = *(const f32x4*)(ropes + pos * 32 + i0); }
#pragma unroll
                for (int m = 0; m < 4; ++m) {
                    const int row = row0 + ai * HALF + m * 16; const float sc = qs * rsv[ai][m];
                    bf16_t* dst = Q + (size_t)pn * (16u << 20) + (size_t)row * 256;
#pragma unroll
                    for (int bj = 0; bj < 2; ++bj) {
                        const int head = 2 * bj + (wc >> 1);
                        const f32x4 x1 = acc[ai][bj][m][0] * sc, x2 = acc[ai][bj][m][1] * sc;
                        const f32x4 o1 = x1 * cc[m] - x2 * ss[m], o2 = x1 * ss[m] + x2 * cc[m];
                        u32x2 w1, w2; w1.x = cvt_pk_bf16(o1[0], o1[1]); w1.y = cvt_pk_bf16(o1[2], o1[3]); w2.x = cvt_pk_bf16(o2[0], o2[1]); w2.y = cvt_pk_bf16(o2[2], o2[3]);
                        *(u32x2*)(dst + head * 64 + i0) = w1; *(u32x2*)(dst + head * 64 + 32 + i0) = w2;
                    }
                }
            }
        } else {
            const bool act = (pn == 4 || pn == 5);
#pragma unroll
            for (int ai = 0; ai < 2; ++ai)
#pragma unroll
                for (int m = 0; m < 4; ++m) {
                    const int row = row0 + ai * HALF + m * 16; const float rs = rsv[ai][m];
                    bf16_t* dst = V + (size_t)((pn - 2) >> 1) * (32u << 20) + (size_t)row * 512 + (pn & 1) * 256 + wc * 32 + 8 * fq;
#pragma unroll
                    for (int bj = 0; bj < 2; ++bj) {
                        f32x4 v0 = acc[ai][bj][m][0] * rs, v1 = acc[ai][bj][m][1] * rs;
                        if (act) { v0 = silu4(v0); v1 = silu4(v1); }
                        u32x4 w; w.x = cvt_pk_bf16(v0[0], v0[1]); w.y = cvt_pk_bf16(v0[2], v0[3]); w.z = cvt_pk_bf16(v1[0], v1[1]); w.w = cvt_pk_bf16(v1[2], v1[3]);
                        *(u32x4*)(dst + bj * HALF) = w;
                    }
                }
        }
    }
};

template <class Epi, class Sched, bool ALIGN_EPI = false, bool SP2 = false, bool ATILED = false>
__device__ __forceinline__ void gemm_phase(PG8_LAS unsigned char* lds, const Gemm g, const Sched& S, const Epi& E) {
    const int tid = threadIdx.x, wid = __builtin_amdgcn_readfirstlane(tid >> 6), lane = tid & 63, wr = wid >> 2, wc = wid & 3, fr = lane & 15, fq = lane >> 4;
    const int K = g.K, nt = K / BK;
    unsigned voffA[2], voffB[2];
#pragma unroll
    for (int i = 0; i < 2; ++i) { int R, C; stage_rc(tid * 16 + i * 8192, R, C); const int Rb = Epi::PERM ? ((R & ~31) + perm32(R & 31)) : R;
        voffA[i] = (unsigned)(R * (ATILED ? BK : K) + C) * 2u; voffB[i] = (unsigned)(Rb * K + C) * 2u; }
    const size_t kstep = (size_t)(BK * 2);
    const size_t hstep = (size_t)HALF * K * 2;
    const size_t tstep = 2 * hstep;
    const size_t kstepA = ATILED ? (size_t)(BM * BK * 2) : kstep, hstepA = ATILED ? (size_t)(HALF * BK * 2) : hstep, tstepA = ATILED ? (size_t)nt * (BM * BK * 2) : tstep;
    const unsigned ldsw = (unsigned)wid * 1024u;
    const int aoff = lds_byte(wr * 64 + fr, fq * 8), boff = lds_byte(wc * 32 + fr, fq * 8);
#define PG8_SA(b, h) (((b) * 2 + (h)) * HTB)
#define PG8_SB(b, h) ((4 + (b) * 2 + (h)) * HTB)
#define PG8_STAGE(bufoff, gbase, voff) do { _Pragma("unroll") for (int _i = 0; _i < 2; ++_i) \
        __builtin_amdgcn_global_load_lds((const unsigned*)((const char*)(gbase) + (voff)[_i]), (PG8_LAS unsigned*)(lds + (bufoff) + ldsw + _i * 8192), 16, 0, 0); } while (0)
#define PG8_LDA(dst, b, h) do { _Pragma("unroll") for (int m = 0; m < 4; ++m) _Pragma("unroll") for (int k = 0; k < 2; ++k) dst[m][k] = *(const PG8_LAS bf16x8*)(lds + PG8_SA(b, h) + aoff + m * 2048 + k * 1024); } while (0)
#define PG8_LDB(dst, b, h) do { _Pragma("unroll") for (int n = 0; n < 2; ++n) _Pragma("unroll") for (int k = 0; k < 2; ++k) dst[n][k] = *(const PG8_LAS bf16x8*)(lds + PG8_SB(b, h) + boff + n * 2048 + k * 1024); } while (0)
#define PG8_MMA(ai, bj, At, Bt) do { __builtin_amdgcn_s_setprio(1); _Pragma("unroll") for (int m = 0; m < 4; ++m) _Pragma("unroll") for (int n = 0; n < 2; ++n) _Pragma("unroll") for (int k = 0; k < 2; ++k) \
        acc[ai][bj][m][n] = __builtin_amdgcn_mfma_f32_16x16x32_bf16(Bt[n][k], At[m][k], acc[ai][bj][m][n], 0, 0, 0); __builtin_amdgcn_s_setprio(0); } while (0)
#define PG8_WAIT_V(n) asm volatile("s_waitcnt vmcnt(" #n ")" ::: "memory")
#define PG8_WAIT_L(n) asm volatile("s_waitcnt lgkmcnt(" #n ")" ::: "memory")
#define PG8_BAR __builtin_amdgcn_s_barrier()
#define PG8_SCHED __builtin_amdgcn_sched_barrier(0)
    Unit cur, nxt; int ui = 0;
    if (!S.next(0, cur)) return;
    f32x4 acc[2][2][4][2];
#pragma unroll
    for (int a = 0; a < 2; ++a)
#pragma unroll
        for (int b = 0; b < 2; ++b)
#pragma unroll
            for (int m = 0; m < 4; ++m)
#pragma unroll
                for (int n = 0; n < 2; ++n) acc[a][b][m][n] = (f32x4){0.f, 0.f, 0.f, 0.f};
    bf16x8 At[4][2], B0[2][2], B1[2][2];
    const char* cA = (const char*)g.A + (size_t)cur.pm * tstepA; const char* cB = (const char*)g.Bt + (size_t)cur.pn * tstep;
    S.a_ready(cur);
    if constexpr (SP2) {
        PG8_STAGE(PG8_SB(0, 0), cB, voffB); PG8_STAGE(PG8_SB(0, 1), cB + hstep, voffB); PG8_STAGE(PG8_SA(0, 0), cA, voffA); PG8_STAGE(PG8_SA(0, 1), cA + hstepA, voffA);
        if (wr == 1) PG8_BAR;
        PG8_WAIT_V(2); PG8_BAR;
        PG8_STAGE(PG8_SB(1, 0), cB + kstep, voffB); PG8_STAGE(PG8_SA(1, 0), cA + kstepA, voffA); PG8_STAGE(PG8_SB(1, 1), cB + hstep + kstep, voffB);
        PG8_WAIT_V(6); PG8_BAR;
    } else {
        PG8_STAGE(PG8_SB(0, 0), cB, voffB); PG8_STAGE(PG8_SA(0, 0), cA, voffA); PG8_STAGE(PG8_SB(0, 1), cB + hstep, voffB); PG8_STAGE(PG8_SA(0, 1), cA + hstepA, voffA);
        if (wr == 1) PG8_BAR;
        PG8_WAIT_V(4); PG8_BAR;
        PG8_STAGE(PG8_SB(1, 0), cB + kstep, voffB); PG8_STAGE(PG8_SA(1, 0), cA + kstepA, voffA); PG8_STAGE(PG8_SB(1, 1), cB + hstep + kstep, voffB);
        PG8_WAIT_V(6); PG8_BAR;
    }
    for (;;) {
        const bool has_next = S.next(ui + 1, nxt);
        const char* nA = has_next ? (const char*)g.A + (size_t)nxt.pm * tstepA : cA; const char* nB = has_next ? (const char*)g.Bt + (size_t)nxt.pn * tstep : cB;
        for (int t = 0; t < nt; t += 2) {
            const bool last = (t == nt - 2);
            const char* a1 = cA + (size_t)(t + 1) * kstepA;
            const char* a2 = last ? nA : cA + (size_t)(t + 2) * kstepA; const char* b2 = last ? nB : cB + (size_t)(t + 2) * kstep;
            const char* a3 = a2 + kstepA; const char* b3 = b2 + kstep;
            if (last && has_next) S.a_ready(nxt);
            if constexpr (SP2) {
            PG8_LDB(B0, 0, 0); PG8_LDB(B1, 0, 1); PG8_SCHED; PG8_LDA(At, 0, 0); PG8_STAGE(PG8_SA(1, 1), a1 + hstepA, voffA);
            PG8_WAIT_V(8); PG8_WAIT_L(0); PG8_BAR; PG8_MMA(0, 0, At, B0); PG8_MMA(0, 1, At, B1); PG8_BAR; PG8_SCHED;
            PG8_LDA(At, 0, 1); PG8_STAGE(PG8_SB(0, 0), b2, voffB); PG8_STAGE(PG8_SB(0, 1), b2 + hstep, voffB); PG8_STAGE(PG8_SA(0, 0), a2, voffA);
            PG8_WAIT_V(8); PG8_WAIT_L(0); PG8_BAR; PG8_MMA(1, 0, At, B0); PG8_MMA(1, 1, At, B1); PG8_BAR; PG8_SCHED;
            PG8_LDB(B0, 1, 0); PG8_LDB(B1, 1, 1); PG8_SCHED; PG8_LDA(At, 1, 0); PG8_STAGE(PG8_SA(0, 1), a2 + hstepA, voffA);
            PG8_WAIT_V(8); PG8_WAIT_L(0); PG8_BAR; PG8_MMA(0, 0, At, B0); PG8_MMA(0, 1, At, B1); PG8_BAR; PG8_SCHED;
            PG8_LDA(At, 1, 1); PG8_STAGE(PG8_SB(1, 0), b3, voffB); PG8_STAGE(PG8_SB(1, 1), b3 + hstep, voffB); PG8_STAGE(PG8_SA(1, 0), a3, voffA);
            PG8_WAIT_V(8); PG8_WAIT_L(0); PG8_BAR; PG8_MMA(1, 0, At, B0); PG8_MMA(1, 1, At, B1); PG8_BAR; PG8_SCHED;
            } else {
            PG8_LDB(B0, 0, 0); PG8_SCHED; PG8_LDA(At, 0, 0); PG8_STAGE(PG8_SA(1, 1), a1 + hstepA, voffA);
            PG8_WAIT_L(8); PG8_BAR; PG8_WAIT_L(0); PG8_MMA(0, 0, At, B0); PG8_BAR; PG8_SCHED;
            PG8_LDB(B1, 0, 1); PG8_STAGE(PG8_SB(0, 0), b2, voffB);
            PG8_BAR; PG8_WAIT_L(0); PG8_MMA(0, 1, At, B1); PG8_BAR;
            PG8_LDA(At, 0, 1); PG8_STAGE(PG8_SA(0, 0), a2, voffA);
            PG8_BAR; PG8_WAIT_L(0); PG8_MMA(1, 0, At, B0); PG8_BAR; PG8_SCHED;
            PG8_STAGE(PG8_SB(0, 1), b2 + hstep, voffB);
            PG8_WAIT_V(6); PG8_BAR; PG8_MMA(1, 1, At, B1); PG8_BAR;
            PG8_LDB(B0, 1, 0); PG8_SCHED; PG8_LDA(At, 1, 0); PG8_STAGE(PG8_SA(0, 1), a2 + hstepA, voffA);
            PG8_WAIT_L(8); PG8_BAR; PG8_WAIT_L(0); PG8_MMA(0, 0, At, B0); PG8_BAR; PG8_SCHED;
            PG8_LDB(B1, 1, 1); PG8_STAGE(PG8_SB(1, 0), b3, voffB);
            PG8_BAR; PG8_WAIT_L(0); PG8_MMA(0, 1, At, B1); PG8_BAR;
            PG8_LDA(At, 1, 1); PG8_STAGE(PG8_SA(1, 0), a3, voffA);
            PG8_BAR; PG8_WAIT_L(0); PG8_MMA(1, 0, At, B0); PG8_BAR; PG8_SCHED;
            PG8_STAGE(PG8_SB(1, 1), b3 + hstep, voffB);
            PG8_WAIT_V(6); PG8_BAR; PG8_MMA(1, 1, At, B1); PG8_BAR;
            }
        }
        if constexpr (ALIGN_EPI) { if (wr == 0) PG8_BAR; }
        if constexpr (!Epi::AFTER_DRAIN) { E(acc, cur, wr, wc, fr, fq); S.done(cur); }
        if (!has_next) break;
#pragma unroll
        for (int a = 0; a < 2; ++a)
#pragma unroll
            for (int b = 0; b < 2; ++b)
#pragma unroll
                for (int m = 0; m < 4; ++m)
#pragma unroll
                    for (int n = 0; n < 2; ++n) acc[a][b][m][n] = (f32x4){0.f, 0.f, 0.f, 0.f};
        cur = nxt; cA = nA; cB = nB; ++ui;
        if constexpr (ALIGN_EPI) { if (wr == 1) PG8_BAR; }
    }
    PG8_WAIT_V(0);
    if constexpr (!ALIGN_EPI) { if (wr == 0) PG8_BAR; }
    PG8_BAR;
    if constexpr (Epi::AFTER_DRAIN) { E.fused(acc, cur, wr, wc, fr, fq, lds, wid, lane); S.done(cur); }
#undef PG8_SA
#undef PG8_SB
#undef PG8_STAGE
#undef PG8_LDA
#undef PG8_LDB
#undef PG8_MMA
#undef PG8_WAIT_V
#undef PG8_WAIT_L
#undef PG8_BAR
#undef PG8_SCHED
}
}

constexpr int NWAVES = 8, NTHREADS = 512;
constexpr int BATCH = 32, SEQ = 2048, D = 1024, FF = 2816, NGU = 2 * FF, INW = 2048, M = BATCH * SEQ;
constexpr int NPHASE = 8;
#define MK_SANITIZE 0
#ifndef MK_REPEAT_MASK
#define MK_REPEAT_MASK 0
#endif
#define REP(k) for (int rep_ = 0; rep_ <= ((MK_REPEAT_MASK >> (k)) & 1); ++rep_)
#define MK_SKIP_MASK 0
#define MK_NO_RET 0
#define MK_NO_POOL 0
#define MK_POOL_FROM_XB 0
#ifndef MK_N_LAUNCHES
#define MK_N_LAUNCHES 1
#endif
constexpr size_t MiB = 1u << 20;
constexpr size_t WS_XB = 0;
constexpr size_t WS_BIG = 128 * MiB;
constexpr size_t WS_Q = WS_BIG, WS_K = WS_Q + 32 * MiB, WS_V = WS_K + 32 * MiB, WS_SG = WS_V + 64 * MiB, WS_U = WS_SG + 64 * MiB, WS_RS = WS_U + 64 * MiB;
constexpr size_t WS_W = 512 * MiB;
constexpr size_t WS_WGU1 = WS_W, WS_WD1 = WS_WGU1 + (size_t)NGU * D * 2, WS_WGU2 = WS_WD1 + (size_t)D * FF * 2, WS_WD2 = WS_WGU2 + (size_t)NGU * D * 2;
constexpr size_t WS_WIN = WS_WD2 + (size_t)D * FF * 2, WS_WOUT = WS_WIN + (size_t)INW * D * 2, WS_WP = WS_WOUT + (size_t)D * D * 2;
constexpr size_t WS_SSQ = 576 * MiB;
constexpr size_t WS_ROPEC = 584 * MiB, WS_ROPES = WS_ROPEC + 2048 * 32 * 4;
constexpr size_t WS_CTL = 592 * MiB, CTL_BYTES = 131072, CTL_CNT = 65536;
constexpr size_t WS_XBUF = 593 * MiB;
constexpr size_t WS_END = 595 * MiB;
static_assert(WS_K == WS_Q + 32 * MiB && WS_SG == WS_V + 64 * MiB && WS_U == WS_V + 128 * MiB, "EpiWin pointer arithmetic");
static_assert(WS_RS + (size_t)M * D * 2 <= WS_W && WS_BIG + (size_t)M * FF * 2 <= WS_W && WS_WP + 4 * 128 * 128 * 2 <= WS_SSQ, "d_ws map");
constexpr int LDS_BYTES = 147456, LDS_BARST = 147456 - 64;

#define LAS __attribute__((address_space(3)))
typedef unsigned short bf16;
typedef unsigned v4u __attribute__((ext_vector_type(4)));
typedef unsigned v2u __attribute__((ext_vector_type(2)));
typedef float f32x4 __attribute__((ext_vector_type(4)));
typedef short bf16x8 __attribute__((ext_vector_type(8)));
#define LBAR() do { asm volatile("s_waitcnt lgkmcnt(0)" ::: "memory"); __builtin_amdgcn_s_barrier(); asm volatile("" ::: "memory"); } while (0)
__device__ __forceinline__ unsigned f2bf(float f) { return (unsigned)__builtin_bit_cast(unsigned short, (__bf16)f); }
__device__ __forceinline__ unsigned pk2(float lo, float hi) { return pg8::cvt_pk_bf16(lo, hi); }
__device__ __forceinline__ float bflo(unsigned w) { return __builtin_bit_cast(float, w << 16); }
__device__ __forceinline__ float bfhi(unsigned w) { return __builtin_bit_cast(float, w & 0xffff0000u); }
__device__ __forceinline__ float bf2f(unsigned short h) { return __builtin_bit_cast(float, (unsigned)h << 16); }
__device__ __forceinline__ float wave_sum(float v) {
#pragma unroll
    for (int o = 1; o < 64; o <<= 1) v += __shfl_xor(v, o);
    return v;
}
__device__ __forceinline__ f32x4 mfma16(bf16x8 a, bf16x8 b, f32x4 c) { return __builtin_amdgcn_mfma_f32_16x16x32_bf16(a, b, c, 0, 0, 0); }

__device__ const float ROPE_FREQ[32] = {
    1.000000000e+00f, 7.498942614e-01f, 5.623413324e-01f, 4.216965139e-01f, 3.162277639e-01f, 2.371373773e-01f, 1.778279394e-01f, 1.333521307e-01f,
    1.000000015e-01f, 7.498941571e-02f, 5.623413250e-02f, 4.216965288e-02f, 3.162277490e-02f, 2.371373773e-02f, 1.778279431e-02f, 1.333521493e-02f,
    9.999999776e-03f, 7.498941850e-03f, 5.623413250e-03f, 4.216964822e-03f, 3.162277630e-03f, 2.371373586e-03f, 1.778279431e-03f, 1.333521446e-03f,
    1.000000047e-03f, 7.498942432e-04f, 5.623413017e-04f, 4.216965172e-04f, 3.162277571e-04f, 2.371373703e-04f, 1.778279402e-04f, 1.333521504e-04f};

#define RLX_AGENT __ATOMIC_RELAXED, __HIP_MEMORY_SCOPE_AGENT
#define XB_TMO      128
#define XB_XCNT(j)  (256  + 64 * (j))
#define XB_XSUB(j)  (1280 + 64 * (j))
#define XB_XGEN(j)  (2304 + 64 * (j))
#define XB_TOP      3328
#define XB_TOPGEN   3392
#define XCD_BAR_WORDS 3456
#define XB_SPIN_CAP (1u << 18)

__device__ __forceinline__ unsigned xb_ld(unsigned* p)              { return __hip_atomic_load(p, __ATOMIC_RELAXED, __HIP_MEMORY_SCOPE_AGENT); }
__device__ __forceinline__ unsigned xb_add(unsigned* p, unsigned v) { return __hip_atomic_fetch_add(p, v, __ATOMIC_RELAXED, __HIP_MEMORY_SCOPE_AGENT); }
__device__ __forceinline__ unsigned xb_xcc_id() { return (unsigned)__builtin_amdgcn_s_getreg((3 << 11) | 20) & 0xFu; }
#define XB_SPIN(cond, bar) do { unsigned _sp = 0; while (cond) { __builtin_amdgcn_s_sleep(1); \
    if ((++_sp & 255u) == 0u) { if (xb_ld(&(bar)[XB_TMO])) break; if (_sp > XB_SPIN_CAP) { atomicAdd(&(bar)[XB_TMO], 1u); break; } } } } while (0)

struct XcdBarrier {
    unsigned* bar; unsigned x;
    volatile LAS unsigned* st;
};

__device__ __forceinline__ XcdBarrier xcd_barrier_post(unsigned* bar, volatile LAS unsigned* st) {
    XcdBarrier b; b.bar = bar; b.x = xb_xcc_id(); b.st = st;
    if (threadIdx.x == 0) (void)xb_add(&bar[XB_XCNT(b.x)], 1u);
    return b;
}
__device__ __forceinline__ void xcd_barrier_complete(unsigned* bar, unsigned x, unsigned& nloc, unsigned& nx) {
    const unsigned G = gridDim.x * gridDim.y * gridDim.z;
    unsigned sum, cnt, mine, sp = 0u;
    for (;;) {
        sum = 0u; cnt = 0u; mine = 0u;
#pragma unroll
        for (unsigned j = 0; j < 16; ++j) { const unsigned c = xb_ld(&bar[XB_XCNT(j)]); sum += c; cnt += (c > 0u) ? 1u : 0u; mine = (j == x) ? c : mine; }
        if (sum == G) break;
        __builtin_amdgcn_s_sleep(1);
        if ((++sp & 255u) == 0u) { if (xb_ld(&bar[XB_TMO])) break; if (sp > XB_SPIN_CAP) { atomicAdd(&bar[XB_TMO], 1u); break; } }
    }
    nloc = mine > 0u ? mine : 1u; nx = cnt > 0u ? cnt : 1u;
}

__device__ __forceinline__ void xcd_barrier(const XcdBarrier& b) {
    asm volatile("s_waitcnt vmcnt(0)" ::: "memory");
    __syncthreads();
    if (threadIdx.x == 0) {
        unsigned* bar = b.bar;
        __builtin_amdgcn_s_waitcnt(0);
        unsigned nloc = b.st[0], nx = b.st[1];
        if (nloc == 0u) { xcd_barrier_complete(bar, b.x, nloc, nx); b.st[0] = nloc; b.st[1] = nx; }
        const unsigned old = xb_add(&bar[XB_XSUB(b.x)], 1u);
        const unsigned gen = old / nloc;
        if (old + 1u == (gen + 1u) * nloc) {
            __builtin_amdgcn_fence(__ATOMIC_RELEASE, "agent");
            asm volatile("s_waitcnt vmcnt(0)" ::: "memory");
            const unsigned og = xb_add(&bar[XB_TOP], 1u);
            const unsigned tg = og / nx;
            if (og + 1u == (tg + 1u) * nx) xb_add(&bar[XB_TOPGEN], 1u);
            else XB_SPIN(xb_ld(&bar[XB_TOPGEN]) == tg, bar);
            __builtin_amdgcn_fence(__ATOMIC_ACQUIRE, "agent");
            xb_add(&bar[XB_XGEN(b.x)], 1u);
            asm volatile("s_waitcnt vmcnt(0)" ::: "memory");
        } else {
            XB_SPIN(xb_ld(&bar[XB_XGEN(b.x)]) == gen, bar);
            __builtin_amdgcn_fence(__ATOMIC_ACQUIRE, "agent");
            asm volatile("s_waitcnt vmcnt(0)" ::: "memory");
        }
    }
    __syncthreads();
}

__device__ __forceinline__ int wrow(int kind, int n) {
    if (kind == 0) return n;
    if (kind == 1) return 256 * (n >> 7) + (n & 127);
    if (kind == 2) return 256 * (n >> 7) + 128 + (n & 127);
    if (n >= 512) return n;
    const int base = n & ~255, o = n & 255, head = o >> 6, r = o & 63, nn = r >> 5, i = r & 31;
    const int bj = head >> 1, wc = 2 * (head & 1) + (i >> 4), fq = (i & 15) >> 2, e = i & 3;
    return base + 128 * bj + 32 * wc + 8 * fq + 4 * nn + e;
}
__device__ __forceinline__ void p0_transpose_item(const float* W, int K, int N, bf16* WT, int kind, const float* gain, LAS float* scr, int item, int lane) {
    const int nblk = N / 32, kb = item / nblk, nb = item % nblk, k0 = 64 * kb, n0 = 32 * nb;
    float wv[32];
#pragma unroll
    for (int i = 0; i < 32; ++i) wv[i] = W[(size_t)(k0 + 2 * i + (lane >> 5)) * N + n0 + (lane & 31)];
    if (gain) {
#pragma unroll
        for (int i = 0; i < 32; ++i) wv[i] *= gain[k0 + 2 * i + (lane >> 5)];
    }
#pragma unroll
    for (int i = 0; i < 32; ++i) scr[(2 * i + (lane >> 5)) * 33 + (lane & 31)] = wv[i];
    asm volatile("s_waitcnt lgkmcnt(0)" ::: "memory");
    const int c = lane & 7;
#pragma unroll
    for (int j = 0; j < 4; ++j) { const int n = (lane >> 3) + 8 * j; const LAS float* s = scr + (8 * c) * 33 + n;
        v4u o; o.x = pk2(s[0 * 33], s[1 * 33]); o.y = pk2(s[2 * 33], s[3 * 33]); o.z = pk2(s[4 * 33], s[5 * 33]); o.w = pk2(s[6 * 33], s[7 * 33]);
        *(v4u*)(WT + (size_t)wrow(kind, n0 + n) * K + k0 + 8 * c) = o; }
    asm volatile("s_waitcnt lgkmcnt(0)" ::: "memory");
}

struct Ptrs {
    const float *x, *n1, *g1, *u1, *d1, *nm, *win, *gng, *pw, *ps, *wout, *n2, *g2, *u2, *d2, *nf;
    float* out;
    bf16 *XB, *ACT, *Q, *K, *V, *SG, *U, *RS, *WGU1, *WD1, *WGU2, *WD2, *WIN, *WOUT, *WP;
    float *SSQ, *ROPEC, *ROPES;
};

__device__ __forceinline__ void p0_prologue(const Ptrs& P, LAS unsigned char* lds, int tid, int lane, int wave) {
    LAS float* scr = (LAS float*)(lds + wave * 16384);
    const int gw = blockIdx.x * NWAVES + wave, NGW = gridDim.x * NWAVES;
    constexpr int I_GU = (D / 64) * (FF / 32), I_DN = (FF / 64) * (D / 32), I_IN = (D / 64) * (INW / 32), I_OUT = (D / 64) * (D / 32);
    constexpr int NITEMS = 4 * I_GU + 2 * I_DN + I_IN + I_OUT;
    for (int it = gw; it < NITEMS; it += NGW) {
        int r = it;
        if (r < I_GU) { p0_transpose_item(P.g1, D, FF, P.WGU1, 1, P.n1, scr, r, lane); continue; } r -= I_GU;
        if (r < I_GU) { p0_transpose_item(P.u1, D, FF, P.WGU1, 2, P.n1, scr, r, lane); continue; } r -= I_GU;
        if (r < I_DN) { p0_transpose_item(P.d1, FF, D, P.WD1, 0, nullptr, scr, r, lane); continue; } r -= I_DN;
        if (r < I_GU) { p0_transpose_item(P.g2, D, FF, P.WGU2, 1, P.n2, scr, r, lane); continue; } r -= I_GU;
        if (r < I_GU) { p0_transpose_item(P.u2, D, FF, P.WGU2, 2, P.n2, scr, r, lane); continue; } r -= I_GU;
        if (r < I_DN) { p0_transpose_item(P.d2, FF, D, P.WD2, 0, nullptr, scr, r, lane); continue; } r -= I_DN;
        if (r < I_IN) { p0_transpose_item(P.win, D, INW, P.WIN, 3, P.nm, scr, r, lane); continue; } r -= I_IN;
        p0_transpose_item(P.wout, D, D, P.WOUT, 0, nullptr, scr, r, lane);
    }
    const int gt = blockIdx.x * NTHREADS + tid, NGT = gridDim.x * NTHREADS;
    for (int i = gt; i < 4 * 128 * 128; i += NGT) { const int g = i >> 14, d = (i >> 7) & 127, c = i & 127; P.WP[i] = (bf16)f2bf(P.pw[(g * 128 + c) * 128 + d] * P.ps[g * 128 + d]); }
    for (int i = gt; i < 2048 * 32; i += NGT) { const int pos = i >> 5; const float ang = (float)pos * ROPE_FREQ[i & 31];
        double rev = (double)ang * 0.15915494309189535; rev -= __builtin_floor(rev); const float rf = (float)rev;
        P.ROPEC[i] = __builtin_amdgcn_cosf(rf); P.ROPES[i] = __builtin_amdgcn_sinf(rf); }
    for (int m = 2 * gw; m < M; m += 2 * NGW) {
        const f32x4* xr = (const f32x4*)(P.x + (size_t)m * D) + lane; f32x4 v[2][4]; float s[2] = {0.f, 0.f};
#pragma unroll
        for (int r = 0; r < 2; ++r)
#pragma unroll
            for (int j = 0; j < 4; ++j) v[r][j] = xr[r * (D / 4) + 64 * j];
#pragma unroll
        for (int r = 0; r < 2; ++r) {
#pragma unroll
            for (int j = 0; j < 4; ++j) s[r] += (v[r][j][0] * v[r][j][0] + v[r][j][1] * v[r][j][1]) + (v[r][j][2] * v[r][j][2] + v[r][j][3] * v[r][j][3]);
            s[r] = wave_sum(s[r]);
            v2u* o8 = (v2u*)(P.XB + (size_t)(m + r) * D) + lane;
#pragma unroll
            for (int j = 0; j < 4; ++j) { v2u w; w.x = pk2(v[r][j][0], v[r][j][1]); w.y = pk2(v[r][j][2], v[r][j][3]); o8[64 * j] = w; }
            if (lane < 16) P.SSQ[(size_t)(m + r) * 16 + lane] = lane == 0 ? s[r] : 0.f;
        }
    }
}

namespace mix {
constexpr int S72 = 72, S136 = 136, S144 = 144;
constexpr int OFF_Q = 0, OFF_K = 9216, OFF_K2 = 18432, OFF_V = 27648, OFF_S = 46080, OFF_ST = 55296, OFF_SG = 73728, OFF_O = 91136, OFF_PART = 108544, OFF_STAT = 124928;
__device__ const float LG2[4] = {-0.04580368961312479f, -0.02272007650008353f, -0.011315313227834146f, -0.005646563141142063f};
__device__ __forceinline__ float ex2(float x) { return __builtin_amdgcn_exp2f(x); }
typedef short s16x4 __attribute__((ext_vector_type(4)));
__device__ __forceinline__ bf16x8 tr_frag(LAS unsigned char* img, int pitch, int c, int ks, int fq, int fr) {
    LAS unsigned char* a0 = img + (32 * ks + 8 * fq + (fr >> 2)) * pitch + 32 * c + 8 * (fr & 3);
    const s16x4 lo = __builtin_amdgcn_ds_read_tr16_b64_v4i16((LAS s16x4*)a0), hi = __builtin_amdgcn_ds_read_tr16_b64_v4i16((LAS s16x4*)(a0 + 4 * pitch));
    return __builtin_shufflevector(lo, hi, 0, 1, 2, 3, 4, 5, 6, 7);
}

constexpr int RSET = 46080, ROFF_Q = 0, ROFF_K = 9216, ROFF_K2 = 18432, ROFF_V = 27648, ROFF_S = 92160, ROFF_ST = 101376, ROFF_PART = 119808, ROFF_STAT = 136192;
__device__ __forceinline__ void retention_unit(LAS unsigned char* lds, const Ptrs& P, int b, int h, int tid) {
    const int lane = tid & 63, w = __builtin_amdgcn_readfirstlane(tid >> 6), fr = lane & 15, fq = lane >> 4;
    const float lg = LG2[h];
    LAS bf16* Ss = (LAS bf16*)(lds + ROFF_S); LAS bf16* St = (LAS bf16*)(lds + ROFF_ST);
    LAS float* part = (LAS float*)(lds + ROFF_PART); LAS float* stat = (LAS float*)(lds + ROFF_STAT);
    for (int i = tid; i < 128 * S72 * 2 / 16; i += NTHREADS) ((LAS v4u*)St)[i] = (v4u){0u, 0u, 0u, 0u};
    f32x4 st[4];
#pragma unroll
    for (int i = 0; i < 4; ++i) st[i] = (f32x4){0.f, 0.f, 0.f, 0.f};
    const int lrow = tid >> 3, lseg = tid & 7, vrow0 = tid >> 4, vseg = tid & 15;
    const size_t tok0 = (size_t)b * SEQ;
    const bf16* gq = P.Q + (tok0 + lrow) * 256 + h * 64 + lseg * 8; const bf16* gk = P.K + (tok0 + lrow) * 256 + h * 64 + lseg * 8;
    const bf16* gv = P.V + (tok0 + vrow0) * 512 + h * 128 + vseg * 8;
    const bf16* gsl = P.SG + (tok0 + fr) * 512 + h * 128 + 16 * w + 4 * fq;
    bf16* gol = P.RS + (tok0 + fr) * 1024 + h * 128 + 16 * w + 4 * fq;
    v4u rq = *(const v4u*)gq, rk = *(const v4u*)gk, rv0 = *(const v4u*)gv, rv1 = *(const v4u*)(gv + 32 * 512);
    const float dkey = ex2((float)(63 - lrow) * lg), dch = ex2(64.f * lg);
    const f32x4 gng4 = *(const f32x4*)(P.gng + h * 128 + 16 * w + 4 * fq);
    const int it3 = w >> 1;
    float dqv[4]; f32x4 decv[2];
#pragma unroll
    for (int it = 0; it < 4; ++it) dqv[it] = ex2((float)(16 * it + fr + 1) * lg);
#pragma unroll
    for (int j2 = 0; j2 < 2; ++j2)
#pragma unroll
        for (int r = 0; r < 4; ++r) decv[j2][r] = ex2(__builtin_fabsf((float)((16 * it3 + fr) - (16 * ((w & 1) * 2 + j2) + 4 * fq + r))) * lg);
    f32x4 op[4]; v2u sgr[4];
#pragma unroll
    for (int it = 0; it < 4; ++it) { op[it] = (f32x4){0.f, 0.f, 0.f, 0.f}; sgr[it] = (v2u){0u, 0u}; }
    for (int n = 0; n <= 32; ++n) {
        LAS unsigned char* bufc = lds + (n & 1) * RSET;
        LAS bf16* Qs = (LAS bf16*)(bufc + ROFF_Q); LAS bf16* Ks = (LAS bf16*)(bufc + ROFF_K); LAS bf16* K2s = (LAS bf16*)(bufc + ROFF_K2); LAS bf16* Vs = (LAS bf16*)(bufc + ROFF_V);
        if (n < 32) {
            *(LAS v4u*)(Qs + lrow * S72 + lseg * 8) = rq; *(LAS v4u*)(Ks + lrow * S72 + lseg * 8) = rk;
            v4u k2;
#pragma unroll
            for (int t = 0; t < 4; ++t) k2[t] = pk2(bflo(rk[t]) * dkey, bfhi(rk[t]) * dkey);
            *(LAS v4u*)(K2s + lrow * S72 + lseg * 8) = k2;
            *(LAS v4u*)(Vs + vrow0 * S144 + vseg * 8) = rv0; *(LAS v4u*)(Vs + (vrow0 + 32) * S144 + vseg * 8) = rv1;
        }
        if (n >= 1) {
#pragma unroll
            for (int it = 0; it < 4; ++it) sgr[it] = *(const v2u*)(gsl + ((size_t)(n - 1) * 64 + 16 * it) * 512);
        }
        LBAR();
        if (n + 1 < 32) { const size_t o4 = (size_t)(n + 1) * 64;
            rq = *(const v4u*)(gq + o4 * 256); rk = *(const v4u*)(gk + o4 * 256); rv0 = *(const v4u*)(gv + o4 * 512); rv1 = *(const v4u*)(gv + (o4 + 32) * 512); }
        if (n >= 1) {
            const int row = tid >> 3, sub = tid & 7;
            const f32x4 pa = *(const LAS f32x4*)(part + (row * 32 + sub * 4) * 2), pb = *(const LAS f32x4*)(part + (row * 32 + sub * 4) * 2 + 4);
            float s1 = (pa[0] + pa[2]) + (pb[0] + pb[2]), s2 = (pa[1] + pa[3]) + (pb[1] + pb[3]);
#pragma unroll
            for (int x = 1; x < 8; x <<= 1) { s1 += __shfl_xor(s1, x); s2 += __shfl_xor(s2, x); }
            if (sub == 0) { const float mean = s1 * (1.f / 128.f); float var = s2 * (1.f / 128.f) - mean * mean; var = var < 0.f ? 0.f : var;
                stat[row * 2] = mean; stat[row * 2 + 1] = __builtin_amdgcn_rsqf(var + 1e-5f); }
        }
        if (n < 32) {
#pragma unroll
            for (int j2 = 0; j2 < 2; ++j2) {
                const int jt = (w & 1) * 2 + j2; f32x4 a4 = (f32x4){0.f, 0.f, 0.f, 0.f};
#pragma unroll
                for (int ks = 0; ks < 2; ++ks) {
                    const bf16x8 qf = *(const LAS bf16x8*)(Qs + (16 * it3 + fr) * S72 + 32 * ks + 8 * fq), kf = *(const LAS bf16x8*)(Ks + (16 * jt + fr) * S72 + 32 * ks + 8 * fq);
                    a4 = mfma16(kf, qf, a4); }
                a4 = a4 * decv[j2];
                v2u pw; pw.x = pk2(a4[0], a4[1]); pw.y = pk2(a4[2], a4[3]);
                *(LAS v2u*)(Ss + (16 * it3 + fr) * S72 + 16 * jt + 4 * fq) = pw;
            }
        }
        LBAR();
        if (n >= 1) {
#pragma unroll
            for (int it = 0; it < 4; ++it) { const int i = 16 * it + fr; const float mean = stat[i * 2], rstd = stat[i * 2 + 1]; const v2u sg = sgr[it];
                const f32x4 y = (op[it] - mean) * rstd * gng4 * (f32x4){bflo(sg.x), bfhi(sg.x), bflo(sg.y), bfhi(sg.y)};
                v2u pw; pw.x = pk2(y[0], y[1]); pw.y = pk2(y[2], y[3]);
                *(v2u*)(gol + ((size_t)(n - 1) * 64 + 16 * it) * 1024) = pw; }
        }
        if (n < 32) {
            f32x4 o[4]; bf16x8 bst[2], bv[2];
#pragma unroll
            for (int ks = 0; ks < 2; ++ks) { bst[ks] = *(const LAS bf16x8*)(St + (16 * w + fr) * S72 + 32 * ks + 8 * fq); bv[ks] = tr_frag(bufc + ROFF_V, S144 * 2, w, ks, fq, fr); }
#pragma unroll
            for (int it = 0; it < 4; ++it) { o[it] = (f32x4){0.f, 0.f, 0.f, 0.f};
#pragma unroll
                for (int ks = 0; ks < 2; ++ks) { const bf16x8 qf = *(const LAS bf16x8*)(Qs + (16 * it + fr) * S72 + 32 * ks + 8 * fq); o[it] = mfma16(bst[ks], qf, o[it]); }
                o[it] = o[it] * dqv[it];
#pragma unroll
                for (int ks = 0; ks < 2; ++ks) { const bf16x8 sf = *(const LAS bf16x8*)(Ss + (16 * it + fr) * S72 + 32 * ks + 8 * fq); o[it] = mfma16(bv[ks], sf, o[it]); }
            }
#pragma unroll
            for (int dt = 0; dt < 4; ++dt) { st[dt] = st[dt] * dch;
#pragma unroll
                for (int ks = 0; ks < 2; ++ks) { const bf16x8 kf = tr_frag(bufc + ROFF_K2, S72 * 2, dt, ks, fq, fr); st[dt] = mfma16(kf, bv[ks], st[dt]); }
                v2u pw; pw.x = pk2(st[dt][0], st[dt][1]); pw.y = pk2(st[dt][2], st[dt][3]);
                *(LAS v2u*)(St + (16 * w + fr) * S72 + 16 * dt + 4 * fq) = pw; }
#pragma unroll
            for (int it = 0; it < 4; ++it) { const f32x4 v = o[it]; typedef float f32x2 __attribute__((ext_vector_type(2)));
                *(LAS f32x2*)(part + ((16 * it + fr) * 32 + w * 4 + fq) * 2) = (f32x2){(v[0] + v[1]) + (v[2] + v[3]), (v[0] * v[0] + v[1] * v[1]) + (v[2] * v[2] + v[3] * v[3])};
                op[it] = v; }
        }
    }
    LBAR();
}

constexpr int POOL_US = 0, POOL_PS = 21504, POOL_YS = POOL_PS + 64 * S136 * 2;
#define POOL_LOAD(tile_) do { _Pragma("unroll") for (int k_ = 0; k_ < 3; ++k_) { const int idx_ = tid + 512 * k_, r_ = idx_ >> 4; \
        const bool ok_ = (idx_ < 79 * 16) && ((((tile_) & 31) != 0) || r_ >= 15); const long grow_ = (long)(tile_) * 64 - 15 + r_; \
        pf[k_] = ok_ ? *(const v4u*)(P.U + (size_t)grow_ * 512 + g * 128 + vseg * 8) : (v4u){0u, 0u, 0u, 0u}; } } while (0)
template <int WIN>
__device__ __forceinline__ void pool_block_t(LAS unsigned char* lds, const Ptrs& P, int g, int tile0, int tstep, int tid) {
    const int lane = tid & 63, w = __builtin_amdgcn_readfirstlane(tid >> 6), fr = lane & 15, fq = lane >> 4;
    LAS bf16* Us = (LAS bf16*)(lds + POOL_US); LAS bf16* Ps = (LAS bf16*)(lds + POOL_PS); LAS bf16* Ys = (LAS bf16*)(lds + POOL_YS);
    bf16x8 bw[4];
#pragma unroll
    for (int ks = 0; ks < 4; ++ks) bw[ks] = *(const bf16x8*)(P.WP + (size_t)(g * 128 + 16 * w + fr) * 128 + 32 * ks + 8 * fq);
    const int vrow0 = tid >> 4, vseg = tid & 15;
    v4u pf[3];
    POOL_LOAD(tile0);
    for (int tile = tile0; tile < M / 64; tile += tstep) {
#pragma unroll
        for (int k = 0; k < 3; ++k) { const int idx = tid + 512 * k; if (idx < 79 * 16) *(LAS v4u*)(Us + (idx >> 4) * S136 + vseg * 8) = pf[k]; }
        LBAR();
        if (tile + tstep < M / 64) POOL_LOAD(tile + tstep);
#pragma unroll
        for (int rep = 0; rep < 2; ++rep) {
            const int row = vrow0 + 32 * rep; const int pos = (tile * 64 + row) & 2047; const int cnt = (pos + 1 < WIN) ? pos + 1 : WIN;
            const v4u cur = *(const LAS v4u*)(Us + (row + 15) * S136 + vseg * 8); float a[8];
#pragma unroll
            for (int k = 0; k < 4; ++k) { a[2 * k] = bflo(cur[k]); a[2 * k + 1] = bfhi(cur[k]); }
#pragma unroll
            for (int tau = 1; tau < WIN; ++tau) { const v4u v = *(const LAS v4u*)(Us + (row + 15 - tau) * S136 + vseg * 8);
#pragma unroll
                for (int k = 0; k < 4; ++k) { a[2 * k] += bflo(v[k]); a[2 * k + 1] += bfhi(v[k]); } }
            const float inv = __builtin_amdgcn_rcpf((float)cnt); v4u o;
#pragma unroll
            for (int k = 0; k < 4; ++k) o[k] = pk2(a[2 * k] * inv - bflo(cur[k]), a[2 * k + 1] * inv - bfhi(cur[k]));
            *(LAS v4u*)(Ps + row * S136 + vseg * 8) = o;
        }
        LBAR();
#pragma unroll
        for (int it = 0; it < 4; ++it) { f32x4 acc = (f32x4){0.f, 0.f, 0.f, 0.f};
#pragma unroll
            for (int ks = 0; ks < 4; ++ks) { const bf16x8 a = *(const LAS bf16x8*)(Ps + (16 * it + fr) * S136 + 32 * ks + 8 * fq); acc = mfma16(bw[ks], a, acc); }
            v2u pw; pw.x = pk2(acc[0], acc[1]); pw.y = pk2(acc[2], acc[3]);
            *(LAS v2u*)(Ys + (16 * it + fr) * S136 + 16 * w + 4 * fq) = pw; }
        LBAR();
#pragma unroll
        for (int rep = 0; rep < 2; ++rep) { const int row = vrow0 + 32 * rep; const size_t t = (size_t)tile * 64 + row;
            *(v4u*)(P.RS + t * 1024 + 512 + g * 128 + vseg * 8) = *(const LAS v4u*)(Ys + row * S136 + vseg * 8); }
    }
    LBAR();
}
__device__ __forceinline__ void pool_block(LAS unsigned char* lds, const Ptrs& P, int pblk, int npblk, int tid) {
    const int g = pblk & 3, tile0 = pblk >> 2, tstep = npblk >> 2;
    if (g == 0) pool_block_t<2>(lds, P, g, tile0, tstep, tid);
    else if (g == 1) pool_block_t<4>(lds, P, g, tile0, tstep, tid);
    else if (g == 2) pool_block_t<8>(lds, P, g, tile0, tstep, tid);
    else pool_block_t<16>(lds, P, g, tile0, tstep, tid);
}
}

struct Args { const float* in[16]; float* out; unsigned char* ws; int ph_lo, ph_hi; };
__global__ void __launch_bounds__(NTHREADS, 2) mk_fwd(Args args) {
    extern __shared__ __attribute__((aligned(16))) unsigned char lds_raw[];
    LAS unsigned char* lds = (LAS unsigned char*)lds_raw;
    const int tid = threadIdx.x, lane = tid & 63, wave = __builtin_amdgcn_readfirstlane(tid >> 6);
    const int G = gridDim.x;
    unsigned char* ws = args.ws;
    Ptrs P;
    P.x = args.in[0]; P.n1 = args.in[1]; P.g1 = args.in[2]; P.u1 = args.in[3]; P.d1 = args.in[4]; P.nm = args.in[5]; P.win = args.in[6]; P.gng = args.in[7];
    P.pw = args.in[8]; P.ps = args.in[9]; P.wout = args.in[10]; P.n2 = args.in[11]; P.g2 = args.in[12]; P.u2 = args.in[13]; P.d2 = args.in[14]; P.nf = args.in[15];
    P.out = args.out;
    P.XB = (bf16*)(ws + WS_XB); P.ACT = (bf16*)(ws + WS_BIG); P.Q = (bf16*)(ws + WS_Q); P.K = (bf16*)(ws + WS_K); P.V = (bf16*)(ws + WS_V); P.SG = (bf16*)(ws + WS_SG);
    P.U = (bf16*)(ws + WS_U); P.RS = (bf16*)(ws + WS_RS);
    P.WGU1 = (bf16*)(ws + WS_WGU1); P.WD1 = (bf16*)(ws + WS_WD1); P.WGU2 = (bf16*)(ws + WS_WGU2); P.WD2 = (bf16*)(ws + WS_WD2); P.WIN = (bf16*)(ws + WS_WIN);
    P.WOUT = (bf16*)(ws + WS_WOUT); P.WP = (bf16*)(ws + WS_WP);
    P.SSQ = (float*)(ws + WS_SSQ); P.ROPEC = (float*)(ws + WS_ROPEC); P.ROPES = (float*)(ws + WS_ROPES);
    const int lo = args.ph_lo, hi = args.ph_hi;
    if (tid < 16) ((LAS unsigned*)(lds + LDS_BARST))[tid] = 0u;
    __syncthreads();
    XcdBarrier xbar; xbar.bar = (unsigned*)(ws + WS_CTL); xbar.x = 0; xbar.st = nullptr;
    if (hi - lo > 1) xbar = xcd_barrier_post((unsigned*)(ws + WS_CTL), (volatile LAS unsigned*)(lds + LDS_BARST));
#define IN(k) (lo <= (k) && (k) < hi)
#define SEAM(k) do { if (IN(k) && IN((k) + 1)) { xcd_barrier(xbar); } } while (0)

    if (lo < 0) cg::this_grid().sync();
    if (IN(0)) { REP(0) p0_prologue(P, lds, tid, lane, wave); SEAM(0); }
    if (IN(1)) {
        pg8::Gemm g{P.XB, P.WGU1, M, NGU, D}; pg8::StaticOrder S; S.init(M, NGU, G, (int)blockIdx.x);
        pg8::EpiSwiGLU E{P.ACT, P.SSQ};
        REP(1) pg8::gemm_phase<pg8::EpiSwiGLU, pg8::StaticOrder, true, true>(lds, g, S, E);
        SEAM(1);
    }
    if (IN(2)) {
        pg8::Gemm g{P.ACT, P.WD1, M, D, FF}; pg8::StaticOrder S; S.init(M, D, G, (int)blockIdx.x);
        pg8::EpiResid E{P.XB, P.XB, P.SSQ, 0.5f};
        REP(2) pg8::gemm_phase<pg8::EpiResid, pg8::StaticOrder, true, true, true>(lds, g, S, E);
        SEAM(2);
    }
    if (IN(3)) {
        pg8::Gemm g{P.XB, P.WIN, M, INW, D}; pg8::StaticOrder S; S.init(M, INW, G, (int)blockIdx.x);
        pg8::EpiWin E{P.Q, P.V, P.SSQ, P.ROPEC, P.ROPES};
        REP(3) pg8::gemm_phase<pg8::EpiWin, pg8::StaticOrder, true, true>(lds, g, S, E);
        SEAM(3);
    }
    if (IN(4)) {
        const int bx = blockIdx.x;
        REP(4)
        if (G >= 8) {
            const int npool = (G / 2) & ~3, nret = G - npool;
            if (bx < nret) {
#if MK_NO_RET
                for (size_t i = (size_t)bx * NTHREADS + tid; i < (size_t)M * 64; i += (size_t)nret * NTHREADS) *(v4u*)(P.RS + (i >> 6) * 1024 + (i & 63) * 8) = (v4u){0u, 0u, 0u, 0u};
#else
                for (int u = bx; u < BATCH * 4; u += nret) mix::retention_unit(lds, P, u >> 2, u & 3, tid);
#endif
            } else {
#if MK_NO_POOL
                for (size_t i = (size_t)(bx - nret) * NTHREADS + tid; i < (size_t)M * 64; i += (size_t)npool * NTHREADS) *(v4u*)(P.RS + (i >> 6) * 1024 + 512 + (i & 63) * 8) = (v4u){0u, 0u, 0u, 0u};
#else
                mix::pool_block(lds, P, bx - nret, npool, tid);
#endif
            }
        } else {
            for (int u = bx; u < BATCH * 4; u += G) mix::retention_unit(lds, P, u >> 2, u & 3, tid);
            for (int pb = bx; pb < 4 * G; pb += G) mix::pool_block(lds, P, pb, 4 * G, tid);
        }
        SEAM(4);
    }
    if (IN(5)) {
        pg8::Gemm g{P.RS, P.WOUT, M, D, D}; pg8::StaticOrder S; S.init(M, D, G, (int)blockIdx.x);
        pg8::EpiResid E{P.XB, P.XB, P.SSQ, 1.0f};
        pg8::gemm_phase<pg8::EpiResid, pg8::StaticOrder, true, true>(lds, g, S, E);
        SEAM(5);
    }
    if (IN(6)) {
        pg8::Gemm g{P.XB, P.WGU2, M, NGU, D}; pg8::StaticOrder S; S.init(M, NGU, G, (int)blockIdx.x);
        pg8::EpiSwiGLU E{P.ACT, P.SSQ};
        REP(6) pg8::gemm_phase<pg8::EpiSwiGLU, pg8::StaticOrder, true, true>(lds, g, S, E);
        SEAM(6);
    }
    if (IN(7)) {
        pg8::Gemm g{P.ACT, P.WD2, M, D, FF}; pg8::StaticOrder S; S.init(M, D, G, (int)blockIdx.x);
        pg8::EpiFinalNorm E{P.XB, P.out, P.nf, (unsigned*)(ws + WS_XBUF), (unsigned*)(ws + WS_CTL + CTL_CNT), lds + pg8::STAGE_BYTES, 0.5f};
        pg8::gemm_phase<pg8::EpiFinalNorm, pg8::StaticOrder, true, true, true>(lds, g, S, E);
    }
#undef IN
#undef SEAM
}

extern "C" void kernel_launch(void* const* d_in, const int* in_sizes, int n_in, void* d_out, int out_size, void* d_ws, size_t ws_size, hipStream_t stream) {
    static int grid = 0;
    if (grid == 0) {
        if (n_in != 16 || in_sizes[0] != M * D || out_size != M * D || ws_size < WS_END) { fprintf(stderr, "kernel_launch: unexpected shapes (n_in %d, in0 %d, out %d, ws %zu); nothing launched\n", n_in, n_in > 0 ? in_sizes[0] : -1, out_size, ws_size); grid = -1; return; }
        int dev = 0, cus = 0, per_cu = 0;
        if (hipGetDevice(&dev) != hipSuccess || hipDeviceGetAttribute(&cus, hipDeviceAttributeMultiprocessorCount, dev) != hipSuccess) { grid = -1; return; }
        if (hipFuncSetAttribute((const void*)mk_fwd, hipFuncAttributeMaxDynamicSharedMemorySize, LDS_BYTES) != hipSuccess) { fprintf(stderr, "kernel_launch: hipFuncSetAttribute failed\n"); grid = -1; return; }
        if (hipOccupancyMaxActiveBlocksPerMultiprocessor(&per_cu, (const void*)mk_fwd, NTHREADS, LDS_BYTES) != hipSuccess || per_cu < 1) { fprintf(stderr, "kernel_launch: occupancy query gave %d\n", per_cu); per_cu = 1; }
        (void)hipGetLastError();
        grid = cus * per_cu;
        if (grid > 256) grid = 256;
        if (grid != 256) fprintf(stderr, "kernel_launch: note: %d co-resident workgroups (expected 256): the fused final-norm exchange assumes 256\n", grid);
    }
    if (grid < 0) return;
    Args a{};
    for (int i = 0; i < 16; ++i) a.in[i] = (const float*)d_in[i];
    a.out = (float*)d_out; a.ws = (unsigned char*)d_ws;
#if MK_N_LAUNCHES == 1
    if (hipMemsetAsync((char*)d_ws + WS_CTL, 0, CTL_BYTES, stream) != hipSuccess) { fprintf(stderr, "kernel_launch: hipMemsetAsync failed\n"); return; }
    a.ph_lo = 0; a.ph_hi = NPHASE;
    void* kargs[] = {&a};
    const hipError_t le = hipLaunchCooperativeKernel((const void*)mk_fwd, dim3(grid), dim3(NTHREADS), kargs, LDS_BYTES, stream);
    if (le != hipSuccess) fprintf(stderr, "kernel_launch: cooperative launch failed: %s (grid %d)\n", hipGetErrorString(le), grid);
#else
    for (int ph = 0; ph < NPHASE; ++ph) {
        if (MK_SKIP_MASK & (1 << ph)) continue;
        a.ph_lo = ph; a.ph_hi = ph + 1;
        hipLaunchKernelGGL(mk_fwd, dim3(grid), dim3(NTHREADS), LDS_BYTES, stream, a);
    }
#endif
}
```

```cpp
#include <hip/hip_runtime.h>
#include <hip/hip_cooperative_groups.h>
#include <cstdio>
#include <cstdint>
namespace cg = cooperative_groups;
namespace pg8 {
#define PG8_LAS __attribute__((address_space(3)))
typedef unsigned short bf16_t;
typedef short bf16x8 __attribute__((ext_vector_type(8)));
typedef float f32x4 __attribute__((ext_vector_type(4)));
typedef unsigned u32x4 __attribute__((ext_vector_type(4)));
constexpr int BM = 256, BK = 64, HALF = 128, HTB = HALF * BK * 2  , STAGE_BYTES = 8 * HTB, NXCD = 8, WGM = 8;

__host__ __device__ __forceinline__ int lds_byte(int r, int c) { const int st = (r >> 4) * 2 + (c >> 5), rr = r & 15, cc = c & 31, ob = rr * 64 + cc * 2; return st * 1024 + (ob ^ (((ob >> 9) & 1) << 5)); }
__host__ __device__ __forceinline__ void stage_rc(int b, int& R, int& C) { const int st = b / 1024, sb = b % 1024, swz = sb ^ (((sb >> 9) & 1) << 5); R = (st >> 1) * 16 + swz / 64; C = (st & 1) * 32 + (swz % 64) / 2; }
__host__ __device__ __forceinline__ int perm32(int rho) { const int n = rho >> 4, i = rho & 15; return 8 * (i >> 2) + 4 * n + (i & 3); }

struct Unit { int pm, pn; };
struct Gemm { const bf16_t* A; const bf16_t* Bt; int M, N, K; };

struct StaticOrder {
    int nM, nN, nwg, G, c;
    __host__ __device__ void init(int M, int N, int G_, int c_) { nM = M / BM; nN = N / BM; nwg = nM * nN; G = G_; c = c_; }
    __host__ __device__ bool next(int i, Unit& u) const {
        const long L = (long)i * G + c; if (L >= nwg) return false;
        int wgid = (int)L; { const int q = nwg / NXCD, r = nwg % NXCD, xcd = wgid % NXCD, off = wgid / NXCD; wgid = (xcd < r ? xcd * (q + 1) : r * (q + 1) + (xcd - r) * q) + off; }
        const int nig = WGM * nN, gid = wgid / nig, fm = gid * WGM, gsz = (nM - fm) < WGM ? (nM - fm) : WGM;
        u.pm = fm + ((wgid % nig) % gsz); u.pn = (wgid % nig) / gsz; return true;
    }
    __device__ __forceinline__ void a_ready(const Unit&) const {}
    __device__ __forceinline__ void done(const Unit&) const {}
};

typedef __bf16 bf16v2 __attribute__((ext_vector_type(2)));
__device__ __forceinline__ unsigned cvt_pk_bf16(float lo, float hi) { typedef float f2 __attribute__((ext_vector_type(2))); const bf16v2 r = __builtin_convertvector((f2){lo, hi}, bf16v2); return __builtin_bit_cast(unsigned, r); }
typedef float f32x2 __attribute__((ext_vector_type(2)));
typedef unsigned u32x2 __attribute__((ext_vector_type(2)));
constexpr int DM = 1024, DFF = 2816;
constexpr float RMS_EPS = 1e-6f;
__device__ __forceinline__ float row_rstd(const float* ssq, int row, int fq) {
    const f32x4 p = *(const f32x4*)(ssq + (size_t)row * 16 + 4 * fq);
    float s = (p[0] + p[1]) + (p[2] + p[3]);
    s += __shfl_xor(s, 16); s += __shfl_xor(s, 32);
    return __builtin_amdgcn_rsqf(s * (1.0f / (float)DM) + RMS_EPS);
}
__device__ __forceinline__ float silu_f(float x) { return x * __builtin_amdgcn_rcpf(1.0f + __builtin_amdgcn_exp2f(-1.4426950408889634f * x)); }
__device__ __forceinline__ f32x4 silu4(f32x4 v) { return (f32x4){silu_f(v[0]), silu_f(v[1]), silu_f(v[2]), silu_f(v[3])}; }

__device__ __forceinline__ void rows_rstd(const float* ssq, int row0, int fq, float (&rs)[2][4]) {
    f32x4 p[2][4];
#pragma unroll
    for (int ai = 0; ai < 2; ++ai)
#pragma unroll
        for (int m = 0; m < 4; ++m) p[ai][m] = *(const f32x4*)(ssq + (size_t)(row0 + ai * HALF + m * 16) * 16 + 4 * fq);
#pragma unroll
    for (int ai = 0; ai < 2; ++ai)
#pragma unroll
        for (int m = 0; m < 4; ++m) { float s = (p[ai][m][0] + p[ai][m][1]) + (p[ai][m][2] + p[ai][m][3]); s += __shfl_xor(s, 16); s += __shfl_xor(s, 32); rs[ai][m] = __builtin_amdgcn_rsqf(s * (1.0f / (float)DM) + RMS_EPS); }
}
struct EpiSwiGLU {
    static constexpr bool PERM = true, AFTER_DRAIN = false;
    bf16_t* O; const float* ssq;
    __device__ __forceinline__ void operator()(const f32x4 (&acc)[2][2][4][2], const Unit& u, int wr, int wc, int fr, int fq) const {
        const int row0 = u.pm * BM + wr * 64 + fr, col0 = u.pn * HALF + wc * 32 + 8 * fq;
        float rsv[2][4]; rows_rstd(ssq, row0, fq, rsv);
#pragma unroll
        for (int ai = 0; ai < 2; ++ai)
#pragma unroll
            for (int m = 0; m < 4; ++m) {
                const int row = row0 + ai * HALF + m * 16; const float rs = rsv[ai][m], cexp = -1.4426950408889634f * rs, rs2 = rs * rs;
                const f32x4 g0 = acc[ai][0][m][0], g1 = acc[ai][0][m][1], u0 = acc[ai][1][m][0], u1 = acc[ai][1][m][1];
                const f32x4 t0 = g0 * cexp, t1 = g1 * cexp;
                f32x4 d0 = (f32x4){__builtin_amdgcn_exp2f(t0[0]), __builtin_amdgcn_exp2f(t0[1]), __builtin_amdgcn_exp2f(t0[2]), __builtin_amdgcn_exp2f(t0[3])} + 1.0f;
                f32x4 d1 = (f32x4){__builtin_amdgcn_exp2f(t1[0]), __builtin_amdgcn_exp2f(t1[1]), __builtin_amdgcn_exp2f(t1[2]), __builtin_amdgcn_exp2f(t1[3])} + 1.0f;
                const f32x4 r0 = (f32x4){__builtin_amdgcn_rcpf(d0[0]), __builtin_amdgcn_rcpf(d0[1]), __builtin_amdgcn_rcpf(d0[2]), __builtin_amdgcn_rcpf(d0[3])} * rs2;
                const f32x4 r1 = (f32x4){__builtin_amdgcn_rcpf(d1[0]), __builtin_amdgcn_rcpf(d1[1]), __builtin_amdgcn_rcpf(d1[2]), __builtin_amdgcn_rcpf(d1[3])} * rs2;
                const f32x4 a0 = (g0 * u0) * r0, a1 = (g1 * u1) * r1;
                u32x4 w; w.x = cvt_pk_bf16(a0[0], a0[1]); w.y = cvt_pk_bf16(a0[2], a0[3]); w.z = cvt_pk_bf16(a1[0], a1[1]); w.w = cvt_pk_bf16(a1[2], a1[3]);
                *(u32x4*)(O + (((size_t)(row >> 8) * (DFF / BK) + (col0 >> 6)) * BM + (row & 255)) * BK + (col0 & 63)) = w;
            }
    }
};
__device__ __forceinline__ void bf8_to_f32(const u32x4 w, f32x4& lo, f32x4& hi) {
    lo = (f32x4){__builtin_bit_cast(float, w.x << 16), __builtin_bit_cast(float, w.x & 0xffff0000u), __builtin_bit_cast(float, w.y << 16), __builtin_bit_cast(float, w.y & 0xffff0000u)};
    hi = (f32x4){__builtin_bit_cast(float, w.z << 16), __builtin_bit_cast(float, w.z & 0xffff0000u), __builtin_bit_cast(float, w.w << 16), __builtin_bit_cast(float, w.w & 0xffff0000u)};
}
struct EpiResid {
    static constexpr bool PERM = true, AFTER_DRAIN = false;
    const bf16_t* base; bf16_t* xb; float* ssq; float alpha;
    __device__ __forceinline__ void operator()(const f32x4 (&acc)[2][2][4][2], const Unit& u, int wr, int wc, int fr, int fq) const {
        const int row0 = u.pm * BM + wr * 64 + fr, col0 = u.pn * BM + wc * 32 + 8 * fq;
#pragma unroll
        for (int ai = 0; ai < 2; ++ai) {
            u32x4 pre[4][2];
#pragma unroll
            for (int m = 0; m < 4; ++m)
#pragma unroll
                for (int bj = 0; bj < 2; ++bj) pre[m][bj] = *(const u32x4*)(base + (size_t)(row0 + ai * HALF + m * 16) * DM + col0 + bj * HALF);
#pragma unroll
            for (int m = 0; m < 4; ++m) {
                const int row = row0 + ai * HALF + m * 16; float q = 0.f;
#pragma unroll
                for (int bj = 0; bj < 2; ++bj) {
                    const size_t off = (size_t)row * DM + col0 + bj * HALF;
                    f32x4 b0, b1; bf8_to_f32(pre[m][bj], b0, b1);
                    const f32x4 o0 = b0 + acc[ai][bj][m][0] * alpha, o1 = b1 + acc[ai][bj][m][1] * alpha;
                    u32x4 w; w.x = cvt_pk_bf16(o0[0], o0[1]); w.y = cvt_pk_bf16(o0[2], o0[3]); w.z = cvt_pk_bf16(o1[0], o1[1]); w.w = cvt_pk_bf16(o1[2], o1[3]); *(u32x4*)(xb + off) = w;
                    q += (o0[0] * o0[0] + o0[1] * o0[1]) + (o0[2] * o0[2] + o0[3] * o0[3]) + (o1[0] * o1[0] + o1[1] * o1[1]) + (o1[2] * o1[2] + o1[3] * o1[3]);
                }
                q += __shfl_xor(q, 16); q += __shfl_xor(q, 32);
                if (fq == 0) ssq[(size_t)row * 16 + u.pn * 4 + wc] = q;
            }
        }
    }
};
struct EpiFinalNorm {
    static constexpr bool PERM = true, AFTER_DRAIN = false;
    const bf16_t* base; float* out; const float* gain; unsigned* xbuf; unsigned* cnt; PG8_LAS unsigned char* xl; float alpha;
    __device__ __forceinline__ void operator()(f32x4 (&acc)[2][2][4][2], const Unit& u, int wr, int wc, int fr, int fq) const {
        const int wid = wr * 4 + wc, lane = fq * 16 + fr;
        PG8_LAS float* Pt = (PG8_LAS float*)xl; PG8_LAS float* Sr = (PG8_LAS float*)(xl + 4096);
        const int row0 = u.pm * BM + wr * 64 + fr, col0 = u.pn * BM + wc * 32 + 8 * fq;
        f32x4 gv[2][2];
#pragma unroll
        for (int bj = 0; bj < 2; ++bj)
#pragma unroll
            for (int n = 0; n < 2; ++n) gv[bj][n] = *(const f32x4*)(gain + col0 + bj * HALF + 4 * n);
#pragma unroll
        for (int ai = 0; ai < 2; ++ai) {
            u32x4 pre[4][2];
#pragma unroll
            for (int m = 0; m < 4; ++m)
#pragma unroll
                for (int bj = 0; bj < 2; ++bj) pre[m][bj] = *(const u32x4*)(base + (size_t)(row0 + ai * HALF + m * 16) * DM + col0 + bj * HALF);
#pragma unroll
            for (int m = 0; m < 4; ++m) { float q = 0.f;
#pragma unroll
                for (int bj = 0; bj < 2; ++bj) {
                    f32x4 b0, b1; bf8_to_f32(pre[m][bj], b0, b1);
                    const f32x4 o0 = b0 + acc[ai][bj][m][0] * alpha, o1 = b1 + acc[ai][bj][m][1] * alpha;
                    acc[ai][bj][m][0] = o0; acc[ai][bj][m][1] = o1;
                    q += (o0[0] * o0[0] + o0[1] * o0[1]) + (o0[2] * o0[2] + o0[3] * o0[3]) + (o1[0] * o1[0] + o1[1] * o1[1]) + (o1[2] * o1[2] + o1[3] * o1[3]);
                }
                q += __shfl_xor(q, 16); q += __shfl_xor(q, 32);
                if (fq == 0) Pt[(ai * HALF + wr * 64 + m * 16 + fr) * 4 + wc] = q;
            }
        }
        asm volatile("s_waitcnt lgkmcnt(0)" ::: "memory"); __builtin_amdgcn_s_barrier(); asm volatile("" ::: "memory");
        const int row = wid * 32 + (lane & 31);
        if (lane < 32) { const f32x4 p = *(const PG8_LAS f32x4*)(Pt + row * 4);
            __hip_atomic_store(xbuf + (size_t)(u.pm * BM + row) * 4 + u.pn, __builtin_bit_cast(unsigned, (p[0] + p[1]) + (p[2] + p[3])), __ATOMIC_RELAXED, __HIP_MEMORY_SCOPE_AGENT); }
        asm volatile("s_waitcnt vmcnt(0)" ::: "memory");
        if (lane == 0) __hip_atomic_fetch_add(cnt + 64 * u.pm, 1u, __ATOMIC_RELAXED, __HIP_MEMORY_SCOPE_AGENT);
        if (wid == 0) {
            unsigned spins = 0u;
            while ((unsigned)__builtin_amdgcn_readfirstlane(__hip_atomic_load(cnt + 64 * u.pm, __ATOMIC_RELAXED, __HIP_MEMORY_SCOPE_AGENT)) < 32u) { __builtin_amdgcn_s_sleep(2); if (++spins > (1u << 22)) break; }
            __builtin_amdgcn_fence(__ATOMIC_ACQUIRE, "agent");
        }
        asm volatile("s_waitcnt vmcnt(0) lgkmcnt(0)" ::: "memory"); __builtin_amdgcn_s_barrier(); asm volatile("" ::: "memory");
        if (lane < 32) { const unsigned* slot = xbuf + (size_t)(u.pm * BM + row) * 4; float t = 0.f;
#pragma unroll
            for (int k = 0; k < 4; ++k) t += __builtin_bit_cast(float, __hip_atomic_load(slot + k, __ATOMIC_RELAXED, __HIP_MEMORY_SCOPE_AGENT));
            Sr[row] = __builtin_amdgcn_rsqf(t * (1.0f / (float)DM) + RMS_EPS); }
        asm volatile("s_waitcnt lgkmcnt(0)" ::: "memory"); __builtin_amdgcn_s_barrier(); asm volatile("" ::: "memory");
#pragma unroll
        for (int ai = 0; ai < 2; ++ai)
#pragma unroll
            for (int m = 0; m < 4; ++m) { const float rs = Sr[ai * HALF + wr * 64 + m * 16 + fr];
#pragma unroll
                for (int bj = 0; bj < 2; ++bj) { const size_t off = (size_t)(row0 + ai * HALF + m * 16) * DM + col0 + bj * HALF;
                    *(f32x4*)(out + off) = acc[ai][bj][m][0] * rs * gv[bj][0]; *(f32x4*)(out + off + 4) = acc[ai][bj][m][1] * rs * gv[bj][1]; } }
    }
};
struct EpiWin {
    static constexpr bool PERM = true, AFTER_DRAIN = false;
    bf16_t *Q, *V; const float* ssq; const float* ropec; const float* ropes;
    __device__ __forceinline__ void operator()(const f32x4 (&acc)[2][2][4][2], const Unit& u, int wr, int wc, int fr, int fq) const {
        const int row0 = u.pm * BM + wr * 64 + fr, pn = u.pn;
        float rsv[2][4]; rows_rstd(ssq, row0, fq, rsv);
        if (pn < 2) {
            const int i0 = 16 * (wc & 1) + 4 * fq; const float qs = pn == 0 ? 0.125f : 1.0f;
#pragma unroll
            for (int ai = 0; ai < 2; ++ai) {
                f32x4 cc[4], ss[4];
#pragma unroll
                for (int m = 0; m < 4; ++m) { const int pos = (row0 + ai * HALF + m * 16) & 2047; cc[m] = *(const f32x4*)(ropec + pos * 32 + i0); ss[m] = *(const f32x4*)(ropes + pos * 32 + i0); }
#pragma unroll
                for (int m = 0; m < 4; ++m) {
                    const int row = row0 + ai * HALF + m * 16; const float sc = qs * rsv[ai][m];
                    bf16_t* dst = Q + (size_t)pn * (16u << 20) + (size_t)row * 256;
#pragma unroll
                    for (int bj = 0; bj < 2; ++bj) {
                        const int head = 2 * bj + (wc >> 1);
                        const f32x4 x1 = acc[ai][bj][m][0] * sc, x2 = acc[ai][bj][m][1] * sc;
                        const f32x4 o1 = x1 * cc[m] - x2 * ss[m], o2 = x1 * ss[m] + x2 * cc[m];
                        u32x2 w1, w2; w1.x = cvt_pk_bf16(o1[0], o1[1]); w1.y = cvt_pk_bf16(o1[2], o1[3]); w2.x = cvt_pk_bf16(o2[0], o2[1]); w2.y = cvt_pk_bf16(o2[2], o2[3]);
                        *(u32x2*)(dst + head * 64 + i0) = w1; *(u32x2*)(dst + head * 64 + 32 + i0) = w2;
                    }
                }
            }
        } else {
            const bool act = (pn == 4 || pn == 5);
#pragma unroll
            for (int ai = 0; ai < 2; ++ai)
#pragma unroll
                for (int m = 0; m < 4; ++m) {
                    const int row = row0 + ai * HALF + m * 16; const float rs = rsv[ai][m];
                    bf16_t* dst = V + (size_t)((pn - 2) >> 1) * (32u << 20) + (size_t)row * 512 + (pn & 1) * 256 + wc * 32 + 8 * fq;
#pragma unroll
                    for (int bj = 0; bj < 2; ++bj) {
                        f32x4 v0 = acc[ai][bj][m][0] * rs, v1 = acc[ai][bj][m][1] * rs;
                        if (act) { v0 = silu4(v0); v1 = silu4(v1); }
                        u32x4 w; w.x = cvt_pk_bf16(v0[0], v0[1]); w.y = cvt_pk_bf16(v0[2], v0[3]); w.z = cvt_pk_bf16(v1[0], v1[1]); w.w = cvt_pk_bf16(v1[2], v1[3]);
                        *(u32x4*)(dst + bj * HALF) = w;
                    }
                }
        }
    }
};

template <class Epi, class Sched, bool ALIGN_EPI = false, bool SP2 = false, bool ATILED = false>
__device__ __forceinline__ void gemm_phase(PG8_LAS unsigned char* lds, const Gemm g, const Sched& S, const Epi& E) {
    const int tid = threadIdx.x, wid = __builtin_amdgcn_readfirstlane(tid >> 6), lane = tid & 63, wr = wid >> 2, wc = wid & 3, fr = lane & 15, fq = lane >> 4;
    const int K = g.K, nt = K / BK;
    unsigned voffA[2], voffB[2];
#pragma unroll
    for (int i = 0; i < 2; ++i) { int R, C; stage_rc(tid * 16 + i * 8192, R, C); const int Rb = Epi::PERM ? ((R & ~31) + perm32(R & 31)) : R;
        voffA[i] = (unsigned)(R * (ATILED ? BK : K) + C) * 2u; voffB[i] = (unsigned)(Rb * K + C) * 2u; }
    const size_t kstep = (size_t)(BK * 2);
    const size_t hstep = (size_t)HALF * K * 2;
    const size_t tstep = 2 * hstep;
    const size_t kstepA = ATILED ? (size_t)(BM * BK * 2) : kstep, hstepA = ATILED ? (size_t)(HALF * BK * 2) : hstep, tstepA = ATILED ? (size_t)nt * (BM * BK * 2) : tstep;
    const unsigned ldsw = (unsigned)wid * 1024u;
    const int aoff = lds_byte(wr * 64 + fr, fq * 8), boff = lds_byte(wc * 32 + fr, fq * 8);
#define PG8_SA(b, h) (((b) * 2 + (h)) * HTB)
#define PG8_SB(b, h) ((4 + (b) * 2 + (h)) * HTB)
#define PG8_STAGE(bufoff, gbase, voff) do { _Pragma("unroll") for (int _i = 0; _i < 2; ++_i) \
        __builtin_amdgcn_global_load_lds((const unsigned*)((const char*)(gbase) + (voff)[_i]), (PG8_LAS unsigned*)(lds + (bufoff) + ldsw + _i * 8192), 16, 0, 0); } while (0)
#define PG8_LDA(dst, b, h) do { _Pragma("unroll") for (int m = 0; m < 4; ++m) _Pragma("unroll") for (int k = 0; k < 2; ++k) dst[m][k] = *(const PG8_LAS bf16x8*)(lds + PG8_SA(b, h) + aoff + m * 2048 + k * 1024); } while (0)
#define PG8_LDB(dst, b, h) do { _Pragma("unroll") for (int n = 0; n < 2; ++n) _Pragma("unroll") for (int k = 0; k < 2; ++k) dst[n][k] = *(const PG8_LAS bf16x8*)(lds + PG8_SB(b, h) + boff + n * 2048 + k * 1024); } while (0)
#define PG8_MMA(ai, bj, At, Bt) do { __builtin_amdgcn_s_setprio(1); _Pragma("unroll") for (int m = 0; m < 4; ++m) _Pragma("unroll") for (int n = 0; n < 2; ++n) _Pragma("unroll") for (int k = 0; k < 2; ++k) \
        acc[ai][bj][m][n] = __builtin_amdgcn_mfma_f32_16x16x32_bf16(Bt[n][k], At[m][k], acc[ai][bj][m][n], 0, 0, 0); __builtin_amdgcn_s_setprio(0); } while (0)
#define PG8_WAIT_V(n) asm volatile("s_waitcnt vmcnt(" #n ")" ::: "memory")
#define PG8_WAIT_L(n) asm volatile("s_waitcnt lgkmcnt(" #n ")" ::: "memory")
#define PG8_BAR __builtin_amdgcn_s_barrier()
#define PG8_SCHED __builtin_amdgcn_sched_barrier(0)
    Unit cur, nxt; int ui = 0;
    if (!S.next(0, cur)) return;
    f32x4 acc[2][2][4][2];
#pragma unroll
    for (int a = 0; a < 2; ++a)
#pragma unroll
        for (int b = 0; b < 2; ++b)
#pragma unroll
            for (int m = 0; m < 4; ++m)
#pragma unroll
                for (int n = 0; n < 2; ++n) acc[a][b][m][n] = (f32x4){0.f, 0.f, 0.f, 0.f};
    bf16x8 At[4][2], B0[2][2], B1[2][2];
    const char* cA = (const char*)g.A + (size_t)cur.pm * tstepA; const char* cB = (const char*)g.Bt + (size_t)cur.pn * tstep;
    S.a_ready(cur);
    if constexpr (SP2) {
        PG8_STAGE(PG8_SB(0, 0), cB, voffB); PG8_STAGE(PG8_SB(0, 1), cB + hstep, voffB); PG8_STAGE(PG8_SA(0, 0), cA, voffA); PG8_STAGE(PG8_SA(0, 1), cA + hstepA, voffA);
        if (wr == 1) PG8_BAR;
        PG8_WAIT_V(2); PG8_BAR;
        PG8_STAGE(PG8_SB(1, 0), cB + kstep, voffB); PG8_STAGE(PG8_SA(1, 0), cA + kstepA, voffA); PG8_STAGE(PG8_SB(1, 1), cB + hstep + kstep, voffB);
        PG8_WAIT_V(6); PG8_BAR;
    } else {
        PG8_STAGE(PG8_SB(0, 0), cB, voffB); PG8_STAGE(PG8_SA(0, 0), cA, voffA); PG8_STAGE(PG8_SB(0, 1), cB + hstep, voffB); PG8_STAGE(PG8_SA(0, 1), cA + hstepA, voffA);
        if (wr == 1) PG8_BAR;
        PG8_WAIT_V(4); PG8_BAR;
        PG8_STAGE(PG8_SB(1, 0), cB + kstep, voffB); PG8_STAGE(PG8_SA(1, 0), cA + kstepA, voffA); PG8_STAGE(PG8_SB(1, 1), cB + hstep + kstep, voffB);
        PG8_WAIT_V(6); PG8_BAR;
    }
    for (;;) {
        const bool has_next = S.next(ui + 1, nxt);
        const char* nA = has_next ? (const char*)g.A + (size_t)nxt.pm * tstepA : cA; const char* nB = has_next ? (const char*)g.Bt + (size_t)nxt.pn * tstep : cB;
        for (int t = 0; t < nt; t += 2) {
            const bool last = (t == nt - 2);
            const char* a1 = cA + (size_t)(t + 1) * kstepA;
            const char* a2 = last ? nA : cA + (size_t)(t + 2) * kstepA; const char* b2 = last ? nB : cB + (size_t)(t + 2) * kstep;
            const char* a3 = a2 + kstepA; const char* b3 = b2 + kstep;
            if (last && has_next) S.a_ready(nxt);
            if constexpr (SP2) {
            PG8_LDB(B0, 0, 0); PG8_LDB(B1, 0, 1); PG8_SCHED; PG8_LDA(At, 0, 0); PG8_STAGE(PG8_SA(1, 1), a1 + hstepA, voffA);
            PG8_WAIT_V(8); PG8_WAIT_L(0); PG8_BAR; PG8_MMA(0, 0, At, B0); PG8_MMA(0, 1, At, B1); PG8_BAR; PG8_SCHED;
            PG8_LDA(At, 0, 1); PG8_STAGE(PG8_SB(0, 0), b2, voffB); PG8_STAGE(PG8_SB(0, 1), b2 + hstep, voffB); PG8_STAGE(PG8_SA(0, 0), a2, voffA);
            PG8_WAIT_V(8); PG8_WAIT_L(0); PG8_BAR; PG8_MMA(1, 0, At, B0); PG8_MMA(1, 1, At, B1); PG8_BAR; PG8_SCHED;
            PG8_LDB(B0, 1, 0); PG8_LDB(B1, 1, 1); PG8_SCHED; PG8_LDA(At, 1, 0); PG8_STAGE(PG8_SA(0, 1), a2 + hstepA, voffA);
            PG8_WAIT_V(8); PG8_WAIT_L(0); PG8_BAR; PG8_MMA(0, 0, At, B0); PG8_MMA(0, 1, At, B1); PG8_BAR; PG8_SCHED;
            PG8_LDA(At, 1, 1); PG8_STAGE(PG8_SB(1, 0), b3, voffB); PG8_STAGE(PG8_SB(1, 1), b3 + hstep, voffB); PG8_STAGE(PG8_SA(1, 0), a3, voffA);
            PG8_WAIT_V(8); PG8_WAIT_L(0); PG8_BAR; PG8_MMA(1, 0, At, B0); PG8_MMA(1, 1, At, B1); PG8_BAR; PG8_SCHED;
            } else {
            PG8_LDB(B0, 0, 0); PG8_SCHED; PG8_LDA(At, 0, 0); PG8_STAGE(PG8_SA(1, 1), a1 + hstepA, voffA);
            PG8_WAIT_L(8); PG8_BAR; PG8_WAIT_L(0); PG8_MMA(0, 0, At, B0); PG8_BAR; PG8_SCHED;
            PG8_LDB(B1, 0, 1); PG8_STAGE(PG8_SB(0, 0), b2, voffB);
            PG8_BAR; PG8_WAIT_L(0); PG8_MMA(0, 1, At, B1); PG8_BAR;
            PG8_LDA(At, 0, 1); PG8_STAGE(PG8_SA(0, 0), a2, voffA);
            PG8_BAR; PG8_WAIT_L(0); PG8_MMA(1, 0, At, B0); PG8_BAR; PG8_SCHED;
            PG8_STAGE(PG8_SB(0, 1), b2 + hstep, voffB);
            PG8_WAIT_V(6); PG8_BAR; PG8_MMA(1, 1, At, B1); PG8_BAR;
            PG8_LDB(B0, 1, 0); PG8_SCHED; PG8_LDA(At, 1, 0); PG8_STAGE(PG8_SA(0, 1), a2 + hstepA, voffA);
            PG8_WAIT_L(8); PG8_BAR; PG8_WAIT_L(0); PG8_MMA(0, 0, At, B0); PG8_BAR; PG8_SCHED;
            PG8_LDB(B1, 1, 1); PG8_STAGE(PG8_SB(1, 0), b3, voffB);
            PG8_BAR; PG8_WAIT_L(0); PG8_MMA(0, 1, At, B1); PG8_BAR;
            PG8_LDA(At, 1, 1); PG8_STAGE(PG8_SA(1, 0), a3, voffA);
            PG8_BAR; PG8_WAIT_L(0); PG8_MMA(1, 0, At, B0); PG8_BAR; PG8_SCHED;
            PG8_STAGE(PG8_SB(1, 1), b3 + hstep, voffB);
            PG8_WAIT_V(6); PG8_BAR; PG8_MMA(1, 1, At, B1); PG8_BAR;
            }
        }
        if constexpr (ALIGN_EPI) { if (wr == 0) PG8_BAR; }
        if constexpr (!Epi::AFTER_DRAIN) { E(acc, cur, wr, wc, fr, fq); S.done(cur); }
        if (!has_next) break;
#pragma unroll
        for (int a = 0; a < 2; ++a)
#pragma unroll
            for (int b = 0; b < 2; ++b)
#pragma unroll
                for (int m = 0; m < 4; ++m)
#pragma unroll
                    for (int n = 0; n < 2; ++n) acc[a][b][m][n] = (f32x4){0.f, 0.f, 0.f, 0.f};
        cur = nxt; cA = nA; cB = nB; ++ui;
        if constexpr (ALIGN_EPI) { if (wr == 1) PG8_BAR; }
    }
    PG8_WAIT_V(0);
    if constexpr (!ALIGN_EPI) { if (wr == 0) PG8_BAR; }
    PG8_BAR;
    if constexpr (Epi::AFTER_DRAIN) { E.fused(acc, cur, wr, wc, fr, fq, lds, wid, lane); S.done(cur); }
#undef PG8_SA
#undef PG8_SB
#undef PG8_STAGE
#undef PG8_LDA
#undef PG8_LDB
#undef PG8_MMA
#undef PG8_WAIT_V
#undef PG8_WAIT_L
#undef PG8_BAR
#undef PG8_SCHED
}
}

constexpr int NWAVES = 8, NTHREADS = 512;
constexpr int BATCH = 32, SEQ = 2048, D = 1024, FF = 2816, NGU = 2 * FF, INW = 2048, M = BATCH * SEQ;
constexpr int NPHASE = 8;
#define MK_SANITIZE 0
#ifndef MK_REPEAT_MASK
#define MK_REPEAT_MASK 0
#endif
#define REP(k) for (int rep_ = 0; rep_ <= ((MK_REPEAT_MASK >> (k)) & 1); ++rep_)
#define MK_SKIP_MASK 0
#define MK_NO_RET 0
#define MK_NO_POOL 0
#define MK_POOL_FROM_XB 0
#ifndef MK_N_LAUNCHES
#define MK_N_LAUNCHES 1
#endif
constexpr size_t MiB = 1u << 20;
constexpr size_t WS_XB = 0;
constexpr size_t WS_BIG = 128 * MiB;
constexpr size_t WS_Q = WS_BIG, WS_K = WS_Q + 32 * MiB, WS_V = WS_K + 32 * MiB, WS_SG = WS_V + 64 * MiB, WS_U = WS_SG + 64 * MiB, WS_RS = WS_U + 64 * MiB;
constexpr size_t WS_W = 512 * MiB;
constexpr size_t WS_WGU1 = WS_W, WS_WD1 = WS_WGU1 + (size_t)NGU * D * 2, WS_WGU2 = WS_WD1 + (size_t)D * FF * 2, WS_WD2 = WS_WGU2 + (size_t)NGU * D * 2;
constexpr size_t WS_WIN = WS_WD2 + (size_t)D * FF * 2, WS_WOUT = WS_WIN + (size_t)INW * D * 2, WS_WP = WS_WOUT + (size_t)D * D * 2;
constexpr size_t WS_SSQ = 576 * MiB;
constexpr size_t WS_ROPEC = 584 * MiB, WS_ROPES = WS_ROPEC + 2048 * 32 * 4;
constexpr size_t WS_CTL = 592 * MiB, CTL_BYTES = 131072, CTL_CNT = 65536;
constexpr size_t WS_XBUF = 593 * MiB;
constexpr size_t WS_END = 595 * MiB;
static_assert(WS_K == WS_Q + 32 * MiB && WS_SG == WS_V + 64 * MiB && WS_U == WS_V + 128 * MiB, "EpiWin pointer arithmetic");
static_assert(WS_RS + (size_t)M * D * 2 <= WS_W && WS_BIG + (size_t)M * FF * 2 <= WS_W && WS_WP + 4 * 128 * 128 * 2 <= WS_SSQ, "d_ws map");
constexpr int LDS_BYTES = 147456, LDS_BARST = 147456 - 64;

#define LAS __attribute__((address_space(3)))
typedef unsigned short bf16;
typedef unsigned v4u __attribute__((ext_vector_type(4)));
typedef unsigned v2u __attribute__((ext_vector_type(2)));
typedef float f32x4 __attribute__((ext_vector_type(4)));
typedef short bf16x8 __attribute__((ext_vector_type(8)));
#define LBAR() do { asm volatile("s_waitcnt lgkmcnt(0)" ::: "memory"); __builtin_amdgcn_s_barrier(); asm volatile("" ::: "memory"); } while (0)
__device__ __forceinline__ unsigned f2bf(float f) { return (unsigned)__builtin_bit_cast(unsigned short, (__bf16)f); }
__device__ __forceinline__ unsigned pk2(float lo, float hi) { return pg8::cvt_pk_bf16(lo, hi); }
__device__ __forceinline__ float bflo(unsigned w) { return __builtin_bit_cast(float, w << 16); }
__device__ __forceinline__ float bfhi(unsigned w) { return __builtin_bit_cast(float, w & 0xffff0000u); }
__device__ __forceinline__ float bf2f(unsigned short h) { return __builtin_bit_cast(float, (unsigned)h << 16); }
__device__ __forceinline__ float wave_sum(float v) {
#pragma unroll
    for (int o = 1; o < 64; o <<= 1) v += __shfl_xor(v, o);
    return v;
}
__device__ __forceinline__ f32x4 mfma16(bf16x8 a, bf16x8 b, f32x4 c) { return __builtin_amdgcn_mfma_f32_16x16x32_bf16(a, b, c, 0, 0, 0); }

__device__ const float ROPE_FREQ[32] = {
    1.000000000e+00f, 7.498942614e-01f, 5.623413324e-01f, 4.216965139e-01f, 3.162277639e-01f, 2.371373773e-01f, 1.778279394e-01f, 1.333521307e-01f,
    1.000000015e-01f, 7.498941571e-02f, 5.623413250e-02f, 4.216965288e-02f, 3.162277490e-02f, 2.371373773e-02f, 1.778279431e-02f, 1.333521493e-02f,
    9.999999776e-03f, 7.498941850e-03f, 5.623413250e-03f, 4.216964822e-03f, 3.162277630e-03f, 2.371373586e-03f, 1.778279431e-03f, 1.333521446e-03f,
    1.000000047e-03f, 7.498942432e-04f, 5.623413017e-04f, 4.216965172e-04f, 3.162277571e-04f, 2.371373703e-04f, 1.778279402e-04f, 1.333521504e-04f};

#define RLX_AGENT __ATOMIC_RELAXED, __HIP_MEMORY_SCOPE_AGENT
#define XB_TMO      128
#define XB_XCNT(j)  (256  + 64 * (j))
#define XB_XSUB(j)  (1280 + 64 * (j))
#define XB_XGEN(j)  (2304 + 64 * (j))
#define XB_TOP      3328
#define XB_TOPGEN   3392
#define XCD_BAR_WORDS 3456
#define XB_SPIN_CAP (1u << 18)

__device__ __forceinline__ unsigned xb_ld(unsigned* p)              { return __hip_atomic_load(p, __ATOMIC_RELAXED, __HIP_MEMORY_SCOPE_AGENT); }
__device__ __forceinline__ unsigned xb_add(unsigned* p, unsigned v) { return __hip_atomic_fetch_add(p, v, __ATOMIC_RELAXED, __HIP_MEMORY_SCOPE_AGENT); }
__device__ __forceinline__ unsigned xb_xcc_id() { return (unsigned)__builtin_amdgcn_s_getreg((3 << 11) | 20) & 0xFu; }
#define XB_SPIN(cond, bar) do { unsigned _sp = 0; while (cond) { __builtin_amdgcn_s_sleep(1); \
    if ((++_sp & 255u) == 0u) { if (xb_ld(&(bar)[XB_TMO])) break; if (_sp > XB_SPIN_CAP) { atomicAdd(&(bar)[XB_TMO], 1u); break; } } } } while (0)

struct XcdBarrier {
    unsigned* bar; unsigned x;
    volatile LAS unsigned* st;
};

__device__ __forceinline__ XcdBarrier xcd_barrier_post(unsigned* bar, volatile LAS unsigned* st) {
    XcdBarrier b; b.bar = bar; b.x = xb_xcc_id(); b.st = st;
    if (threadIdx.x == 0) (void)xb_add(&bar[XB_XCNT(b.x)], 1u);
    return b;
}
__device__ __forceinline__ void xcd_barrier_complete(unsigned* bar, unsigned x, unsigned& nloc, unsigned& nx) {
    const unsigned G = gridDim.x * gridDim.y * gridDim.z;
    unsigned sum, cnt, mine, sp = 0u;
    for (;;) {
        sum = 0u; cnt = 0u; mine = 0u;
#pragma unroll
        for (unsigned j = 0; j < 16; ++j) { const unsigned c = xb_ld(&bar[XB_XCNT(j)]); sum += c; cnt += (c > 0u) ? 1u : 0u; mine = (j == x) ? c : mine; }
        if (sum == G) break;
        __builtin_amdgcn_s_sleep(1);
        if ((++sp & 255u) == 0u) { if (xb_ld(&bar[XB_TMO])) break; if (sp > XB_SPIN_CAP) { atomicAdd(&bar[XB_TMO], 1u); break; } }
    }
    nloc = mine > 0u ? mine : 1u; nx = cnt > 0u ? cnt : 1u;
}

__device__ __forceinline__ void xcd_barrier(const XcdBarrier& b) {
    asm volatile("s_waitcnt vmcnt(0)" ::: "memory");
    __syncthreads();
    if (threadIdx.x == 0) {
        unsigned* bar = b.bar;
        __builtin_amdgcn_s_waitcnt(0);
        unsigned nloc = b.st[0], nx = b.st[1];
        if (nloc == 0u) { xcd_barrier_complete(bar, b.x, nloc, nx); b.st[0] = nloc; b.st[1] = nx; }
        const unsigned old = xb_add(&bar[XB_XSUB(b.x)], 1u);
        const unsigned gen = old / nloc;
        if (old + 1u == (gen + 1u) * nloc) {
            __builtin_amdgcn_fence(__ATOMIC_RELEASE, "agent");
            asm volatile("s_waitcnt vmcnt(0)" ::: "memory");
            const unsigned og = xb_add(&bar[XB_TOP], 1u);
            const unsigned tg = og / nx;
            if (og + 1u == (tg + 1u) * nx) xb_add(&bar[XB_TOPGEN], 1u);
            else XB_SPIN(xb_ld(&bar[XB_TOPGEN]) == tg, bar);
            __builtin_amdgcn_fence(__ATOMIC_ACQUIRE, "agent");
            xb_add(&bar[XB_XGEN(b.x)], 1u);
            asm volatile("s_waitcnt vmcnt(0)" ::: "memory");
        } else {
            XB_SPIN(xb_ld(&bar[XB_XGEN(b.x)]) == gen, bar);
            __builtin_amdgcn_fence(__ATOMIC_ACQUIRE, "agent");
            asm volatile("s_waitcnt vmcnt(0)" ::: "memory");
        }
    }
    __syncthreads();
}

__device__ __forceinline__ int wrow(int kind, int n) {
    if (kind == 0) return n;
    if (kind == 1) return 256 * (n >> 7) + (n & 127);
    if (kind == 2) return 256 * (n >> 7) + 128 + (n & 127);
    if (n >= 512) return n;
    const int base = n & ~255, o = n & 255, head = o >> 6, r = o & 63, nn = r >> 5, i = r & 31;
    const int bj = head >> 1, wc = 2 * (head & 1) + (i >> 4), fq = (i & 15) >> 2, e = i & 3;
    return base + 128 * bj + 32 * wc + 8 * fq + 4 * nn + e;
}
__device__ __forceinline__ void p0_transpose_item(const float* W, int K, int N, bf16* WT, int kind, const float* gain, LAS float* scr, int item, int lane) {
    const int nblk = N / 32, kb = item / nblk, nb = item % nblk, k0 = 64 * kb, n0 = 32 * nb;
    float wv[32];
#pragma unroll
    for (int i = 0; i < 32; ++i) wv[i] = W[(size_t)(k0 + 2 * i + (lane >> 5)) * N + n0 + (lane & 31)];
    if (gain) {
#pragma unroll
        for (int i = 0; i < 32; ++i) wv[i] *= gain[k0 + 2 * i + (lane >> 5)];
    }
#pragma unroll
    for (int i = 0; i < 32; ++i) scr[(2 * i + (lane >> 5)) * 33 + (lane & 31)] = wv[i];
    asm volatile("s_waitcnt lgkmcnt(0)" ::: "memory");
    const int c = lane & 7;
#pragma unroll
    for (int j = 0; j < 4; ++j) { const int n = (lane >> 3) + 8 * j; const LAS float* s = scr + (8 * c) * 33 + n;
        v4u o; o.x = pk2(s[0 * 33], s[1 * 33]); o.y = pk2(s[2 * 33], s[3 * 33]); o.z = pk2(s[4 * 33], s[5 * 33]); o.w = pk2(s[6 * 33], s[7 * 33]);
        *(v4u*)(WT + (size_t)wrow(kind, n0 + n) * K + k0 + 8 * c) = o; }
    asm volatile("s_waitcnt lgkmcnt(0)" ::: "memory");
}

struct Ptrs {
    const float *x, *n1, *g1, *u1, *d1, *nm, *win, *gng, *pw, *ps, *wout, *n2, *g2, *u2, *d2, *nf;
    float* out;
    bf16 *XB, *ACT, *Q, *K, *V, *SG, *U, *RS, *WGU1, *WD1, *WGU2, *WD2, *WIN, *WOUT, *WP;
    float *SSQ, *ROPEC, *ROPES;
};

__device__ __forceinline__ void p0_prologue(const Ptrs& P, LAS unsigned char* lds, int tid, int lane, int wave) {
    LAS float* scr = (LAS float*)(lds + wave * 16384);
    const int gw = blockIdx.x * NWAVES + wave, NGW = gridDim.x * NWAVES;
    constexpr int I_GU = (D / 64) * (FF / 32), I_DN = (FF / 64) * (D / 32), I_IN = (D / 64) * (INW / 32);
    constexpr int NITEMS = 2 * I_GU + I_DN + I_IN;
    for (int it = gw; it < NITEMS; it += NGW) {
        int r = it;
        if (r < I_GU) { p0_transpose_item(P.g1, D, FF, P.WGU1, 1, P.n1, scr, r, lane); continue; } r -= I_GU;
        if (r < I_GU) { p0_transpose_item(P.u1, D, FF, P.WGU1, 2, P.n1, scr, r, lane); continue; } r -= I_GU;
        if (r < I_DN) { p0_transpose_item(P.d1, FF, D, P.WD1, 0, nullptr, scr, r, lane); continue; } r -= I_DN;
        p0_transpose_item(P.win, D, INW, P.WIN, 3, P.nm, scr, r, lane);
    }
    const int gt = blockIdx.x * NTHREADS + tid, NGT = gridDim.x * NTHREADS;
    for (int i = gt; i < 4 * 128 * 128; i += NGT) { const int g = i >> 14, d = (i >> 7) & 127, c = i & 127; P.WP[i] = (bf16)f2bf(P.pw[(g * 128 + c) * 128 + d] * P.ps[g * 128 + d]); }
    for (int i = gt; i < 2048 * 32; i += NGT) { const int pos = i >> 5; const float ang = (float)pos * ROPE_FREQ[i & 31];
        double rev = (double)ang * 0.15915494309189535; rev -= __builtin_floor(rev); const float rf = (float)rev;
        P.ROPEC[i] = __builtin_amdgcn_cosf(rf); P.ROPES[i] = __builtin_amdgcn_sinf(rf); }
    for (int m = 2 * gw; m < M; m += 2 * NGW) {
        const f32x4* xr = (const f32x4*)(P.x + (size_t)m * D) + lane; f32x4 v[2][4]; float s[2] = {0.f, 0.f};
#pragma unroll
        for (int r = 0; r < 2; ++r)
#pragma unroll
            for (int j = 0; j < 4; ++j) v[r][j] = xr[r * (D / 4) + 64 * j];
#pragma unroll
        for (int r = 0; r < 2; ++r) {
#pragma unroll
            for (int j = 0; j < 4; ++j) s[r] += (v[r][j][0] * v[r][j][0] + v[r][j][1] * v[r][j][1]) + (v[r][j][2] * v[r][j][2] + v[r][j][3] * v[r][j][3]);
            s[r] = wave_sum(s[r]);
            v2u* o8 = (v2u*)(P.XB + (size_t)(m + r) * D) + lane;
#pragma unroll
            for (int j = 0; j < 4; ++j) { v2u w; w.x = pk2(v[r][j][0], v[r][j][1]); w.y = pk2(v[r][j][2], v[r][j][3]); o8[64 * j] = w; }
            if (lane < 16) P.SSQ[(size_t)(m + r) * 16 + lane] = lane == 0 ? s[r] : 0.f;
        }
    }
}

__device__ __forceinline__ void late_weights(const Ptrs& P, LAS unsigned char* lds, int wblk, int nwblk, int lane, int wave) {
    LAS float* scr = (LAS float*)(lds + wave * 16384);
    const int gw = wblk * NWAVES + wave, NGW = nwblk * NWAVES;
    constexpr int I_GU = (D / 64) * (FF / 32), I_DN = (FF / 64) * (D / 32), I_OUT = (D / 64) * (D / 32);
    constexpr int NITEMS = I_OUT + 2 * I_GU + I_DN;
    for (int it = gw; it < NITEMS; it += NGW) {
        int r = it;
        if (r < I_OUT) { p0_transpose_item(P.wout, D, D, P.WOUT, 0, nullptr, scr, r, lane); continue; } r -= I_OUT;
        if (r < I_GU) { p0_transpose_item(P.g2, D, FF, P.WGU2, 1, P.n2, scr, r, lane); continue; } r -= I_GU;
        if (r < I_GU) { p0_transpose_item(P.u2, D, FF, P.WGU2, 2, P.n2, scr, r, lane); continue; } r -= I_GU;
        p0_transpose_item(P.d2, FF, D, P.WD2, 0, nullptr, scr, r, lane);
    }
}

namespace mix {
constexpr int S72 = 72, S136 = 136, S144 = 144;
constexpr int OFF_Q = 0, OFF_K = 9216, OFF_K2 = 18432, OFF_V = 27648, OFF_S = 46080, OFF_ST = 55296, OFF_SG = 73728, OFF_O = 91136, OFF_PART = 108544, OFF_STAT = 124928;
__device__ const float LG2[4] = {-0.04580368961312479f, -0.02272007650008353f, -0.011315313227834146f, -0.005646563141142063f};
__device__ __forceinline__ float ex2(float x) { return __builtin_amdgcn_exp2f(x); }
typedef short s16x4 __attribute__((ext_vector_type(4)));
__device__ __forceinline__ bf16x8 tr_frag(LAS unsigned char* img, int pitch, int c, int ks, int fq, int fr) {
    LAS unsigned char* a0 = img + (32 * ks + 8 * fq + (fr >> 2)) * pitch + 32 * c + 8 * (fr & 3);
    const s16x4 lo = __builtin_amdgcn_ds_read_tr16_b64_v4i16((LAS s16x4*)a0), hi = __builtin_amdgcn_ds_read_tr16_b64_v4i16((LAS s16x4*)(a0 + 4 * pitch));
    return __builtin_shufflevector(lo, hi, 0, 1, 2, 3, 4, 5, 6, 7);
}

constexpr int RSET = 46080, ROFF_Q = 0, ROFF_K = 9216, ROFF_K2 = 18432, ROFF_V = 27648, ROFF_S = 92160, ROFF_ST = 101376, ROFF_PART = 119808, ROFF_STAT = 136192;
__device__ __forceinline__ void retention_unit(LAS unsigned char* lds, const Ptrs& P, int b, int h, int tid) {
    const int lane = tid & 63, w = __builtin_amdgcn_readfirstlane(tid >> 6), fr = lane & 15, fq = lane >> 4;
    const float lg = LG2[h];
    LAS bf16* Ss = (LAS bf16*)(lds + ROFF_S); LAS bf16* St = (LAS bf16*)(lds + ROFF_ST);
    LAS float* part = (LAS float*)(lds + ROFF_PART); LAS float* stat = (LAS float*)(lds + ROFF_STAT);
    for (int i = tid; i < 128 * S72 * 2 / 16; i += NTHREADS) ((LAS v4u*)St)[i] = (v4u){0u, 0u, 0u, 0u};
    f32x4 st[4];
#pragma unroll
    for (int i = 0; i < 4; ++i) st[i] = (f32x4){0.f, 0.f, 0.f, 0.f};
    const int lrow = tid >> 3, lseg = tid & 7, vrow0 = tid >> 4, vseg = tid & 15;
    const size_t tok0 = (size_t)b * SEQ;
    const bf16* gq = P.Q + (tok0 + lrow) * 256 + h * 64 + lseg * 8; const bf16* gk = P.K + (tok0 + lrow) * 256 + h * 64 + lseg * 8;
    const bf16* gv = P.V + (tok0 + vrow0) * 512 + h * 128 + vseg * 8;
    const bf16* gsl = P.SG + (tok0 + fr) * 512 + h * 128 + 16 * w + 4 * fq;
    bf16* gol = P.RS + (tok0 + fr) * 1024 + h * 128 + 16 * w + 4 * fq;
    v4u rq = *(const v4u*)gq, rk = *(const v4u*)gk, rv0 = *(const v4u*)gv, rv1 = *(const v4u*)(gv + 32 * 512);
    const float dkey = ex2((float)(63 - lrow) * lg), dch = ex2(64.f * lg);
    const f32x4 gng4 = *(const f32x4*)(P.gng + h * 128 + 16 * w + 4 * fq);
    const int it3 = w >> 1;
    float dqv[4]; f32x4 decv[2];
#pragma unroll
    for (int it = 0; it < 4; ++it) dqv[it] = ex2((float)(16 * it + fr + 1) * lg);
#pragma unroll
    for (int j2 = 0; j2 < 2; ++j2)
#pragma unroll
        for (int r = 0; r < 4; ++r) decv[j2][r] = ex2(__builtin_fabsf((float)((16 * it3 + fr) - (16 * ((w & 1) * 2 + j2) + 4 * fq + r))) * lg);
    f32x4 op[4]; v2u sgr[4];
#pragma unroll
    for (int it = 0; it < 4; ++it) { op[it] = (f32x4){0.f, 0.f, 0.f, 0.f}; sgr[it] = (v2u){0u, 0u}; }
    for (int n = 0; n <= 32; ++n) {
        LAS unsigned char* bufc = lds + (n & 1) * RSET;
        LAS bf16* Qs = (LAS bf16*)(bufc + ROFF_Q); LAS bf16* Ks = (LAS bf16*)(bufc + ROFF_K); LAS bf16* K2s = (LAS bf16*)(bufc + ROFF_K2); LAS bf16* Vs = (LAS bf16*)(bufc + ROFF_V);
        if (n < 32) {
            *(LAS v4u*)(Qs + lrow * S72 + lseg * 8) = rq; *(LAS v4u*)(Ks + lrow * S72 + lseg * 8) = rk;
            v4u k2;
#pragma unroll
            for (int t = 0; t < 4; ++t) k2[t] = pk2(bflo(rk[t]) * dkey, bfhi(rk[t]) * dkey);
            *(LAS v4u*)(K2s + lrow * S72 + lseg * 8) = k2;
            *(LAS v4u*)(Vs + vrow0 * S144 + vseg * 8) = rv0; *(LAS v4u*)(Vs + (vrow0 + 32) * S144 + vseg * 8) = rv1;
        }
        if (n >= 1) {
#pragma unroll
            for (int it = 0; it < 4; ++it) sgr[it] = *(const v2u*)(gsl + ((size_t)(n - 1) * 64 + 16 * it) * 512);
        }
        LBAR();
        if (n + 1 < 32) { const size_t o4 = (size_t)(n + 1) * 64;
            rq = *(const v4u*)(gq + o4 * 256); rk = *(const v4u*)(gk + o4 * 256); rv0 = *(const v4u*)(gv + o4 * 512); rv1 = *(const v4u*)(gv + (o4 + 32) * 512); }
        if (n >= 1) {
            const int row = tid >> 3, sub = tid & 7;
            const f32x4 pa = *(const LAS f32x4*)(part + (row * 32 + sub * 4) * 2), pb = *(const LAS f32x4*)(part + (row * 32 + sub * 4) * 2 + 4);
            float s1 = (pa[0] + pa[2]) + (pb[0] + pb[2]), s2 = (pa[1] + pa[3]) + (pb[1] + pb[3]);
#pragma unroll
            for (int x = 1; x < 8; x <<= 1) { s1 += __shfl_xor(s1, x); s2 += __shfl_xor(s2, x); }
            if (sub == 0) { const float mean = s1 * (1.f / 128.f); float var = s2 * (1.f / 128.f) - mean * mean; var = var < 0.f ? 0.f : var;
                stat[row * 2] = mean; stat[row * 2 + 1] = __builtin_amdgcn_rsqf(var + 1e-5f); }
        }
        if (n < 32) {
#pragma unroll
            for (int j2 = 0; j2 < 2; ++j2) {
                const int jt = (w & 1) * 2 + j2; f32x4 a4 = (f32x4){0.f, 0.f, 0.f, 0.f};
#pragma unroll
                for (int ks = 0; ks < 2; ++ks) {
                    const bf16x8 qf = *(const LAS bf16x8*)(Qs + (16 * it3 + fr) * S72 + 32 * ks + 8 * fq), kf = *(const LAS bf16x8*)(Ks + (16 * jt + fr) * S72 + 32 * ks + 8 * fq);
                    a4 = mfma16(kf, qf, a4); }
                a4 = a4 * decv[j2];
                v2u pw; pw.x = pk2(a4[0], a4[1]); pw.y = pk2(a4[2], a4[3]);
                *(LAS v2u*)(Ss + (16 * it3 + fr) * S72 + 16 * jt + 4 * fq) = pw;
            }
        }
        LBAR();
        if (n >= 1) {
#pragma unroll
            for (int it = 0; it < 4; ++it) { const int i = 16 * it + fr; const float mean = stat[i * 2], rstd = stat[i * 2 + 1]; const v2u sg = sgr[it];
                const f32x4 y = (op[it] - mean) * rstd * gng4 * (f32x4){bflo(sg.x), bfhi(sg.x), bflo(sg.y), bfhi(sg.y)};
                v2u pw; pw.x = pk2(y[0], y[1]); pw.y = pk2(y[2], y[3]);
                *(v2u*)(gol + ((size_t)(n - 1) * 64 + 16 * it) * 1024) = pw; }
        }
        if (n < 32) {
            f32x4 o[4]; bf16x8 bst[2], bv[2];
#pragma unroll
            for (int ks = 0; ks < 2; ++ks) { bst[ks] = *(const LAS bf16x8*)(St + (16 * w + fr) * S72 + 32 * ks + 8 * fq); bv[ks] = tr_frag(bufc + ROFF_V, S144 * 2, w, ks, fq, fr); }
#pragma unroll
            for (int it = 0; it < 4; ++it) { o[it] = (f32x4){0.f, 0.f, 0.f, 0.f};
#pragma unroll
                for (int ks = 0; ks < 2; ++ks) { const bf16x8 qf = *(const LAS bf16x8*)(Qs + (16 * it + fr) * S72 + 32 * ks + 8 * fq); o[it] = mfma16(bst[ks], qf, o[it]); }
                o[it] = o[it] * dqv[it];
#pragma unroll
                for (int ks = 0; ks < 2; ++ks) { const bf16x8 sf = *(const LAS bf16x8*)(Ss + (16 * it + fr) * S72 + 32 * ks + 8 * fq); o[it] = mfma16(bv[ks], sf, o[it]); }
            }
#pragma unroll
            for (int dt = 0; dt < 4; ++dt) { st[dt] = st[dt] * dch;
#pragma unroll
                for (int ks = 0; ks < 2; ++ks) { const bf16x8 kf = tr_frag(bufc + ROFF_K2, S72 * 2, dt, ks, fq, fr); st[dt] = mfma16(kf, bv[ks], st[dt]); }
                v2u pw; pw.x = pk2(st[dt][0], st[dt][1]); pw.y = pk2(st[dt][2], st[dt][3]);
                *(LAS v2u*)(St + (16 * w + fr) * S72 + 16 * dt + 4 * fq) = pw; }
#pragma unroll
            for (int it = 0; it < 4; ++it) { const f32x4 v = o[it]; typedef float f32x2 __attribute__((ext_vector_type(2)));
                *(LAS f32x2*)(part + ((16 * it + fr) * 32 + w * 4 + fq) * 2) = (f32x2){(v[0] + v[1]) + (v[2] + v[3]), (v[0] * v[0] + v[1] * v[1]) + (v[2] * v[2] + v[3] * v[3])};
                op[it] = v; }
        }
    }
    LBAR();
}

constexpr int POOL_US = 0, POOL_PS = 21504, POOL_YS = POOL_PS + 64 * S136 * 2;
#define POOL_LOAD(tile_) do { _Pragma("unroll") for (int k_ = 0; k_ < 3; ++k_) { const int idx_ = tid + 512 * k_, r_ = idx_ >> 4; \
        const bool ok_ = (idx_ < 79 * 16) && ((((tile_) & 31) != 0) || r_ >= 15); const long grow_ = (long)(tile_) * 64 - 15 + r_; \
        pf[k_] = ok_ ? *(const v4u*)(P.U + (size_t)grow_ * 512 + g * 128 + vseg * 8) : (v4u){0u, 0u, 0u, 0u}; } } while (0)
template <int WIN>
__device__ __forceinline__ void pool_block_t(LAS unsigned char* lds, const Ptrs& P, int g, int tile0, int tstep, int tid) {
    const int lane = tid & 63, w = __builtin_amdgcn_readfirstlane(tid >> 6), fr = lane & 15, fq = lane >> 4;
    LAS bf16* Us = (LAS bf16*)(lds + POOL_US); LAS bf16* Ps = (LAS bf16*)(lds + POOL_PS); LAS bf16* Ys = (LAS bf16*)(lds + POOL_YS);
    bf16x8 bw[4];
#pragma unroll
    for (int ks = 0; ks < 4; ++ks) bw[ks] = *(const bf16x8*)(P.WP + (size_t)(g * 128 + 16 * w + fr) * 128 + 32 * ks + 8 * fq);
    const int vrow0 = tid >> 4, vseg = tid & 15;
    v4u pf[3];
    POOL_LOAD(tile0);
    for (int tile = tile0; tile < M / 64; tile += tstep) {
#pragma unroll
        for (int k = 0; k < 3; ++k) { const int idx = tid + 512 * k; if (idx < 79 * 16) *(LAS v4u*)(Us + (idx >> 4) * S136 + vseg * 8) = pf[k]; }
        LBAR();
        if (tile + tstep < M / 64) POOL_LOAD(tile + tstep);
#pragma unroll
        for (int rep = 0; rep < 2; ++rep) {
            const int row = vrow0 + 32 * rep; const int pos = (tile * 64 + row) & 2047; const int cnt = (pos + 1 < WIN) ? pos + 1 : WIN;
            const v4u cur = *(const LAS v4u*)(Us + (row + 15) * S136 + vseg * 8); float a[8];
#pragma unroll
            for (int k = 0; k < 4; ++k) { a[2 * k] = bflo(cur[k]); a[2 * k + 1] = bfhi(cur[k]); }
#pragma unroll
            for (int tau = 1; tau < WIN; ++tau) { const v4u v = *(const LAS v4u*)(Us + (row + 15 - tau) * S136 + vseg * 8);
#pragma unroll
                for (int k = 0; k < 4; ++k) { a[2 * k] += bflo(v[k]); a[2 * k + 1] += bfhi(v[k]); } }
            const float inv = __builtin_amdgcn_rcpf((float)cnt); v4u o;
#pragma unroll
            for (int k = 0; k < 4; ++k) o[k] = pk2(a[2 * k] * inv - bflo(cur[k]), a[2 * k + 1] * inv - bfhi(cur[k]));
            *(LAS v4u*)(Ps + row * S136 + vseg * 8) = o;
        }
        LBAR();
#pragma unroll
        for (int it = 0; it < 4; ++it) { f32x4 acc = (f32x4){0.f, 0.f, 0.f, 0.f};
#pragma unroll
            for (int ks = 0; ks < 4; ++ks) { const bf16x8 a = *(const LAS bf16x8*)(Ps + (16 * it + fr) * S136 + 32 * ks + 8 * fq); acc = mfma16(bw[ks], a, acc); }
            v2u pw; pw.x = pk2(acc[0], acc[1]); pw.y = pk2(acc[2], acc[3]);
            *(LAS v2u*)(Ys + (16 * it + fr) * S136 + 16 * w + 4 * fq) = pw; }
        LBAR();
#pragma unroll
        for (int rep = 0; rep < 2; ++rep) { const int row = vrow0 + 32 * rep; const size_t t = (size_t)tile * 64 + row;
            *(v4u*)(P.RS + t * 1024 + 512 + g * 128 + vseg * 8) = *(const LAS v4u*)(Ys + row * S136 + vseg * 8); }
    }
    LBAR();
}
__device__ __forceinline__ void pool_block(LAS unsigned char* lds, const Ptrs& P, int pblk, int npblk, int tid) {
    const int g = pblk & 3, tile0 = pblk >> 2, tstep = npblk >> 2;
    if (g == 0) pool_block_t<2>(lds, P, g, tile0, tstep, tid);
    else if (g == 1) pool_block_t<4>(lds, P, g, tile0, tstep, tid);
    else if (g == 2) pool_block_t<8>(lds, P, g, tile0, tstep, tid);
    else pool_block_t<16>(lds, P, g, tile0, tstep, tid);
}
}

struct Args { const float* in[16]; float* out; unsigned char* ws; int ph_lo, ph_hi; };
__global__ void __launch_bounds__(NTHREADS, 2) mk_fwd(Args args) {
    extern __shared__ __attribute__((aligned(16))) unsigned char lds_raw[];
    LAS unsigned char* lds = (LAS unsigned char*)lds_raw;
    const int tid = threadIdx.x, lane = tid & 63, wave = __builtin_amdgcn_readfirstlane(tid >> 6);
    const int G = gridDim.x;
    unsigned char* ws = args.ws;
    Ptrs P;
    P.x = args.in[0]; P.n1 = args.in[1]; P.g1 = args.in[2]; P.u1 = args.in[3]; P.d1 = args.in[4]; P.nm = args.in[5]; P.win = args.in[6]; P.gng = args.in[7];
    P.pw = args.in[8]; P.ps = args.in[9]; P.wout = args.in[10]; P.n2 = args.in[11]; P.g2 = args.in[12]; P.u2 = args.in[13]; P.d2 = args.in[14]; P.nf = args.in[15];
    P.out = args.out;
    P.XB = (bf16*)(ws + WS_XB); P.ACT = (bf16*)(ws + WS_BIG); P.Q = (bf16*)(ws + WS_Q); P.K = (bf16*)(ws + WS_K); P.V = (bf16*)(ws + WS_V); P.SG = (bf16*)(ws + WS_SG);
    P.U = (bf16*)(ws + WS_U); P.RS = (bf16*)(ws + WS_RS);
    P.WGU1 = (bf16*)(ws + WS_WGU1); P.WD1 = (bf16*)(ws + WS_WD1); P.WGU2 = (bf16*)(ws + WS_WGU2); P.WD2 = (bf16*)(ws + WS_WD2); P.WIN = (bf16*)(ws + WS_WIN);
    P.WOUT = (bf16*)(ws + WS_WOUT); P.WP = (bf16*)(ws + WS_WP);
    P.SSQ = (float*)(ws + WS_SSQ); P.ROPEC = (float*)(ws + WS_ROPEC); P.ROPES = (float*)(ws + WS_ROPES);
    const int lo = args.ph_lo, hi = args.ph_hi;
    if (tid < 16) ((LAS unsigned*)(lds + LDS_BARST))[tid] = 0u;
    __syncthreads();
    XcdBarrier xbar; xbar.bar = (unsigned*)(ws + WS_CTL); xbar.x = 0; xbar.st = nullptr;
    if (hi - lo > 1) xbar = xcd_barrier_post((unsigned*)(ws + WS_CTL), (volatile LAS unsigned*)(lds + LDS_BARST));
#define IN(k) (lo <= (k) && (k) < hi)
#define SEAM(k) do { if (IN(k) && IN((k) + 1)) { xcd_barrier(xbar); } } while (0)

    if (lo < 0) cg::this_grid().sync();
    if (IN(0)) { REP(0) p0_prologue(P, lds, tid, lane, wave); SEAM(0); }
    if (IN(1)) {
        pg8::Gemm g{P.XB, P.WGU1, M, NGU, D}; pg8::StaticOrder S; S.init(M, NGU, G, (int)blockIdx.x);
        pg8::EpiSwiGLU E{P.ACT, P.SSQ};
        REP(1) pg8::gemm_phase<pg8::EpiSwiGLU, pg8::StaticOrder, true, true>(lds, g, S, E);
        SEAM(1);
    }
    if (IN(2)) {
        pg8::Gemm g{P.ACT, P.WD1, M, D, FF}; pg8::StaticOrder S; S.init(M, D, G, (int)blockIdx.x);
        pg8::EpiResid E{P.XB, P.XB, P.SSQ, 0.5f};
        REP(2) pg8::gemm_phase<pg8::EpiResid, pg8::StaticOrder, true, true, true>(lds, g, S, E);
        SEAM(2);
    }
    if (IN(3)) {
        pg8::Gemm g{P.XB, P.WIN, M, INW, D}; pg8::StaticOrder S; S.init(M, INW, G, (int)blockIdx.x);
        pg8::EpiWin E{P.Q, P.V, P.SSQ, P.ROPEC, P.ROPES};
        REP(3) pg8::gemm_phase<pg8::EpiWin, pg8::StaticOrder, true, true>(lds, g, S, E);
        SEAM(3);
    }
    if (IN(4)) {
        const int bx = blockIdx.x;
        REP(4)
        if (G >= 8) {
            const int npool = (G / 2) & ~3, nret = G - npool;
            if (bx < nret) {
#if MK_NO_RET
                for (size_t i = (size_t)bx * NTHREADS + tid; i < (size_t)M * 64; i += (size_t)nret * NTHREADS) *(v4u*)(P.RS + (i >> 6) * 1024 + (i & 63) * 8) = (v4u){0u, 0u, 0u, 0u};
#else
                for (int u = bx; u < BATCH * 4; u += nret) mix::retention_unit(lds, P, u >> 2, u & 3, tid);
#endif
            } else {
#if MK_NO_POOL
                for (size_t i = (size_t)(bx - nret) * NTHREADS + tid; i < (size_t)M * 64; i += (size_t)npool * NTHREADS) *(v4u*)(P.RS + (i >> 6) * 1024 + 512 + (i & 63) * 8) = (v4u){0u, 0u, 0u, 0u};
#else
                mix::pool_block(lds, P, bx - nret, npool, tid);
#endif
                late_weights(P, lds, bx - nret, npool, lane, wave);
            }
        } else {
            for (int u = bx; u < BATCH * 4; u += G) mix::retention_unit(lds, P, u >> 2, u & 3, tid);
            for (int pb = bx; pb < 4 * G; pb += G) mix::pool_block(lds, P, pb, 4 * G, tid);
            late_weights(P, lds, bx, G, lane, wave);
        }
        SEAM(4);
    }
    if (IN(5)) {
        pg8::Gemm g{P.RS, P.WOUT, M, D, D}; pg8::StaticOrder S; S.init(M, D, G, (int)blockIdx.x);
        pg8::EpiResid E{P.XB, P.XB, P.SSQ, 1.0f};
        pg8::gemm_phase<pg8::EpiResid, pg8::StaticOrder, true, true>(lds, g, S, E);
        SEAM(5);
    }
    if (IN(6)) {
        pg8::Gemm g{P.XB, P.WGU2, M, NGU, D}; pg8::StaticOrder S; S.init(M, NGU, G, (int)blockIdx.x);
        pg8::EpiSwiGLU E{P.ACT, P.SSQ};
        REP(6) pg8::gemm_phase<pg8::EpiSwiGLU, pg8::StaticOrder, true, true>(lds, g, S, E);
        SEAM(6);
    }
    if (IN(7)) {
        pg8::Gemm g{P.ACT, P.WD2, M, D, FF}; pg8::StaticOrder S; S.init(M, D, G, (int)blockIdx.x);
        pg8::EpiFinalNorm E{P.XB, P.out, P.nf, (unsigned*)(ws + WS_XBUF), (unsigned*)(ws + WS_CTL + CTL_CNT), lds + pg8::STAGE_BYTES, 0.5f};
        pg8::gemm_phase<pg8::EpiFinalNorm, pg8::StaticOrder, true, true, true>(lds, g, S, E);
    }
#undef IN
#undef SEAM
}

extern "C" void kernel_launch(void* const* d_in, const int* in_sizes, int n_in, void* d_out, int out_size, void* d_ws, size_t ws_size, hipStream_t stream) {
    static int grid = 0;
    if (grid == 0) {
        if (n_in != 16 || in_sizes[0] != M * D || out_size != M * D || ws_size < WS_END) { fprintf(stderr, "kernel_launch: unexpected shapes (n_in %d, in0 %d, out %d, ws %zu); nothing launched\n", n_in, n_in > 0 ? in_sizes[0] : -1, out_size, ws_size); grid = -1; return; }
        int dev = 0, cus = 0, per_cu = 0;
        if (hipGetDevice(&dev) != hipSuccess || hipDeviceGetAttribute(&cus, hipDeviceAttributeMultiprocessorCount, dev) != hipSuccess) { grid = -1; return; }
        if (hipFuncSetAttribute((const void*)mk_fwd, hipFuncAttributeMaxDynamicSharedMemorySize, LDS_BYTES) != hipSuccess) { fprintf(stderr, "kernel_launch: hipFuncSetAttribute failed\n"); grid = -1; return; }
        if (hipOccupancyMaxActiveBlocksPerMultiprocessor(&per_cu, (const void*)mk_fwd, NTHREADS, LDS_BYTES) != hipSuccess || per_cu < 1) { fprintf(stderr, "kernel_launch: occupancy query gave %d\n", per_cu); per_cu = 1; }
        (void)hipGetLastError();
        grid = cus * per_cu;
        if (grid > 256) grid = 256;
        if (grid != 256) fprintf(stderr, "kernel_launch: note: %d co-resident workgroups (expected 256): the fused final-norm exchange assumes 256\n", grid);
    }
    if (grid < 0) return;
    Args a{};
    for (int i = 0; i < 16; ++i) a.in[i] = (const float*)d_in[i];
    a.out = (float*)d_out; a.ws = (unsigned char*)d_ws;
#if MK_N_LAUNCHES == 1
    if (hipMemsetAsync((char*)d_ws + WS_CTL, 0, CTL_BYTES, stream) != hipSuccess) { fprintf(stderr, "kernel_launch: hipMemsetAsync failed\n"); return; }
    a.ph_lo = 0; a.ph_hi = NPHASE;
    void* kargs[] = {&a};
    const hipError_t le = hipLaunchCooperativeKernel((const void*)mk_fwd, dim3(grid), dim3(NTHREADS), kargs, LDS_BYTES, stream);
    if (le != hipSuccess) fprintf(stderr, "kernel_launch: cooperative launch failed: %s (grid %d)\n", hipGetErrorString(le), grid);
#else
    for (int ph = 0; ph < NPHASE; ++ph) {
        if (MK_SKIP_MASK & (1 << ph)) continue;
        a.ph_lo = ph; a.ph_hi = ph + 1;
        hipLaunchKernelGGL(mk_fwd, dim3(grid), dim3(NTHREADS), LDS_BYTES, stream, a);
    }
#endif
}
```

```cpp
#include <hip/hip_runtime.h>
#include <hip/hip_cooperative_groups.h>
#include <cstdio>
#include <cstdint>
namespace cg = cooperative_groups;
namespace pg8 {
#define PG8_LAS __attribute__((address_space(3)))
typedef unsigned short bf16_t;
typedef short bf16x8 __attribute__((ext_vector_type(8)));
typedef float f32x4 __attribute__((ext_vector_type(4)));
typedef unsigned u32x4 __attribute__((ext_vector_type(4)));
constexpr int BM = 256, BK = 64, HALF = 128, HTB = HALF * BK * 2  , STAGE_BYTES = 8 * HTB, NXCD = 8, WGM = 8;

__host__ __device__ __forceinline__ int lds_byte(int r, int c) { const int st = (r >> 4) * 2 + (c >> 5), rr = r & 15, cc = c & 31, ob = rr * 64 + cc * 2; return st * 1024 + (ob ^ (((ob >> 9) & 1) << 5)); }
__host__ __device__ __forceinline__ void stage_rc(int b, int& R, int& C) { const int st = b / 1024, sb = b % 1024, swz = sb ^ (((sb >> 9) & 1) << 5); R = (st >> 1) * 16 + swz / 64; C = (st & 1) * 32 + (swz % 64) / 2; }
__host__ __device__ __forceinline__ int perm32(int rho) { const int n = rho >> 4, i = rho & 15; return 8 * (i >> 2) + 4 * n + (i & 3); }

struct Unit { int pm, pn; };
struct Gemm { const bf16_t* A; const bf16_t* Bt; int M, N, K; };

struct StaticOrder {
    int nM, nN, nwg, G, c;
    __host__ __device__ void init(int M, int N, int G_, int c_) { nM = M / BM; nN = N / BM; nwg = nM * nN; G = G_; c = c_; }
    __host__ __device__ bool next(int i, Unit& u) const {
        const long L = (long)i * G + c; if (L >= nwg) return false;
        int wgid = (int)L; { const int q = nwg / NXCD, r = nwg % NXCD, xcd = wgid % NXCD, off = wgid / NXCD; wgid = (xcd < r ? xcd * (q + 1) : r * (q + 1) + (xcd - r) * q) + off; }
        const int nig = WGM * nN, gid = wgid / nig, fm = gid * WGM, gsz = (nM - fm) < WGM ? (nM - fm) : WGM;
        u.pm = fm + ((wgid % nig) % gsz); u.pn = (wgid % nig) / gsz; return true;
    }
    __device__ __forceinline__ void a_ready(const Unit&) const {}
    __device__ __forceinline__ void done(const Unit&) const {}
};

typedef __bf16 bf16v2 __attribute__((ext_vector_type(2)));
__device__ __forceinline__ unsigned cvt_pk_bf16(float lo, float hi) { typedef float f2 __attribute__((ext_vector_type(2))); const bf16v2 r = __builtin_convertvector((f2){lo, hi}, bf16v2); return __builtin_bit_cast(unsigned, r); }
typedef float f32x2 __attribute__((ext_vector_type(2)));
typedef unsigned u32x2 __attribute__((ext_vector_type(2)));
constexpr int DM = 1024, DFF = 2816;
constexpr float RMS_EPS = 1e-6f;
__device__ __forceinline__ float row_rstd(const float* ssq, int row, int fq) {
    const f32x4 p = *(const f32x4*)(ssq + (size_t)row * 16 + 4 * fq);
    float s = (p[0] + p[1]) + (p[2] + p[3]);
    s += __shfl_xor(s, 16); s += __shfl_xor(s, 32);
    return __builtin_amdgcn_rsqf(s * (1.0f / (float)DM) + RMS_EPS);
}
__device__ __forceinline__ float silu_f(float x) { return x * __builtin_amdgcn_rcpf(1.0f + __builtin_amdgcn_exp2f(-1.4426950408889634f * x)); }
__device__ __forceinline__ f32x4 silu4(f32x4 v) { return (f32x4){silu_f(v[0]), silu_f(v[1]), silu_f(v[2]), silu_f(v[3])}; }

__device__ __forceinline__ void rows_rstd(const float* ssq, int row0, int fq, float (&rs)[2][4]) {
    f32x4 p[2][4];
#pragma unroll
    for (int ai = 0; ai < 2; ++ai)
#pragma unroll
        for (int m = 0; m < 4; ++m) p[ai][m] = *(const f32x4*)(ssq + (size_t)(row0 + ai * HALF + m * 16) * 16 + 4 * fq);
#pragma unroll
    for (int ai = 0; ai < 2; ++ai)
#pragma unroll
        for (int m = 0; m < 4; ++m) { float s = (p[ai][m][0] + p[ai][m][1]) + (p[ai][m][2] + p[ai][m][3]); s += __shfl_xor(s, 16); s += __shfl_xor(s, 32); rs[ai][m] = __builtin_amdgcn_rsqf(s * (1.0f / (float)DM) + RMS_EPS); }
}
struct EpiSwiGLU {
    static constexpr bool PERM = true, AFTER_DRAIN = false;
    bf16_t* O; const float* ssq;
    __device__ __forceinline__ void operator()(const f32x4 (&acc)[2][2][4][2], const Unit& u, int wr, int wc, int fr, int fq) const {
        const int row0 = u.pm * BM + wr * 64 + fr, col0 = u.pn * HALF + wc * 32 + 8 * fq;
        float rsv[2][4]; rows_rstd(ssq, row0, fq, rsv);
#pragma unroll
        for (int ai = 0; ai < 2; ++ai)
#pragma unroll
            for (int m = 0; m < 4; ++m) {
                const int row = row0 + ai * HALF + m * 16; const float rs = rsv[ai][m], cexp = -1.4426950408889634f * rs, rs2 = rs * rs;
                const f32x4 g0 = acc[ai][0][m][0], g1 = acc[ai][0][m][1], u0 = acc[ai][1][m][0], u1 = acc[ai][1][m][1];
                const f32x4 t0 = g0 * cexp, t1 = g1 * cexp;
                f32x4 d0 = (f32x4){__builtin_amdgcn_exp2f(t0[0]), __builtin_amdgcn_exp2f(t0[1]), __builtin_amdgcn_exp2f(t0[2]), __builtin_amdgcn_exp2f(t0[3])} + 1.0f;
                f32x4 d1 = (f32x4){__builtin_amdgcn_exp2f(t1[0]), __builtin_amdgcn_exp2f(t1[1]), __builtin_amdgcn_exp2f(t1[2]), __builtin_amdgcn_exp2f(t1[3])} + 1.0f;
                const f32x4 r0 = (f32x4){__builtin_amdgcn_rcpf(d0[0]), __builtin_amdgcn_rcpf(d0[1]), __builtin_amdgcn_rcpf(d0[2]), __builtin_amdgcn_rcpf(d0[3])} * rs2;
                const f32x4 r1 = (f32x4){__builtin_amdgcn_rcpf(d1[0]), __builtin_amdgcn_rcpf(d1[1]), __builtin_amdgcn_rcpf(d1[2]), __builtin_amdgcn_rcpf(d1[3])} * rs2;
                const f32x4 a0 = (g0 * u0) * r0, a1 = (g1 * u1) * r1;
                u32x4 w; w.x = cvt_pk_bf16(a0[0], a0[1]); w.y = cvt_pk_bf16(a0[2], a0[3]); w.z = cvt_pk_bf16(a1[0], a1[1]); w.w = cvt_pk_bf16(a1[2], a1[3]);
                *(u32x4*)(O + (((size_t)(row >> 8) * (DFF / BK) + (col0 >> 6)) * BM + (row & 255)) * BK + (col0 & 63)) = w;
            }
    }
};
__device__ __forceinline__ void bf8_to_f32(const u32x4 w, f32x4& lo, f32x4& hi) {
    lo = (f32x4){__builtin_bit_cast(float, w.x << 16), __builtin_bit_cast(float, w.x & 0xffff0000u), __builtin_bit_cast(float, w.y << 16), __builtin_bit_cast(float, w.y & 0xffff0000u)};
    hi = (f32x4){__builtin_bit_cast(float, w.z << 16), __builtin_bit_cast(float, w.z & 0xffff0000u), __builtin_bit_cast(float, w.w << 16), __builtin_bit_cast(float, w.w & 0xffff0000u)};
}
struct EpiResid {
    static constexpr bool PERM = true, AFTER_DRAIN = false;
    const bf16_t* base; bf16_t* xb; float* ssq; float alpha;
    __device__ __forceinline__ void operator()(const f32x4 (&acc)[2][2][4][2], const Unit& u, int wr, int wc, int fr, int fq) const {
        const int row0 = u.pm * BM + wr * 64 + fr, col0 = u.pn * BM + wc * 32 + 8 * fq;
#pragma unroll
        for (int ai = 0; ai < 2; ++ai) {
            u32x4 pre[4][2];
#pragma unroll
            for (int m = 0; m < 4; ++m)
#pragma unroll
                for (int bj = 0; bj < 2; ++bj) pre[m][bj] = *(const u32x4*)(base + (size_t)(row0 + ai * HALF + m * 16) * DM + col0 + bj * HALF);
#pragma unroll
            for (int m = 0; m < 4; ++m) {
                const int row = row0 + ai * HALF + m * 16; float q = 0.f;
#pragma unroll
                for (int bj = 0; bj < 2; ++bj) {
                    const size_t off = (size_t)row * DM + col0 + bj * HALF;
                    f32x4 b0, b1; bf8_to_f32(pre[m][bj], b0, b1);
                    const f32x4 o0 = b0 + acc[ai][bj][m][0] * alpha, o1 = b1 + acc[ai][bj][m][1] * alpha;
                    u32x4 w; w.x = cvt_pk_bf16(o0[0], o0[1]); w.y = cvt_pk_bf16(o0[2], o0[3]); w.z = cvt_pk_bf16(o1[0], o1[1]); w.w = cvt_pk_bf16(o1[2], o1[3]); *(u32x4*)(xb + off) = w;
                    q += (o0[0] * o0[0] + o0[1] * o0[1]) + (o0[2] * o0[2] + o0[3] * o0[3]) + (o1[0] * o1[0] + o1[1] * o1[1]) + (o1[2] * o1[2] + o1[3] * o1[3]);
                }
                q += __shfl_xor(q, 16); q += __shfl_xor(q, 32);
                if (fq == 0) ssq[(size_t)row * 16 + u.pn * 4 + wc] = q;
            }
        }
    }
};
struct EpiFinalNorm {
    static constexpr bool PERM = true, AFTER_DRAIN = false;
    const bf16_t* base; float* out; const float* gain; unsigned* xbuf; unsigned* cnt; PG8_LAS unsigned char* xl; float alpha;
    __device__ __forceinline__ void operator()(f32x4 (&acc)[2][2][4][2], const Unit& u, int wr, int wc, int fr, int fq) const {
        const int wid = wr * 4 + wc, lane = fq * 16 + fr;
        PG8_LAS float* Pt = (PG8_LAS float*)xl; PG8_LAS float* Sr = (PG8_LAS float*)(xl + 4096);
        const int row0 = u.pm * BM + wr * 64 + fr, col0 = u.pn * BM + wc * 32 + 8 * fq;
        f32x4 gv[2][2];
#pragma unroll
        for (int bj = 0; bj < 2; ++bj)
#pragma unroll
            for (int n = 0; n < 2; ++n) gv[bj][n] = *(const f32x4*)(gain + col0 + bj * HALF + 4 * n);
#pragma unroll
        for (int ai = 0; ai < 2; ++ai) {
            u32x4 pre[4][2];
#pragma unroll
            for (int m = 0; m < 4; ++m)
#pragma unroll
                for (int bj = 0; bj < 2; ++bj) pre[m][bj] = *(const u32x4*)(base + (size_t)(row0 + ai * HALF + m * 16) * DM + col0 + bj * HALF);
#pragma unroll
            for (int m = 0; m < 4; ++m) { float q = 0.f;
#pragma unroll
                for (int bj = 0; bj < 2; ++bj) {
                    f32x4 b0, b1; bf8_to_f32(pre[m][bj], b0, b1);
                    const f32x4 o0 = b0 + acc[ai][bj][m][0] * alpha, o1 = b1 + acc[ai][bj][m][1] * alpha;
                    acc[ai][bj][m][0] = o0; acc[ai][bj][m][1] = o1;
                    q += (o0[0] * o0[0] + o0[1] * o0[1]) + (o0[2] * o0[2] + o0[3] * o0[3]) + (o1[0] * o1[0] + o1[1] * o1[1]) + (o1[2] * o1[2] + o1[3] * o1[3]);
                }
                q += __shfl_xor(q, 16); q += __shfl_xor(q, 32);
                if (fq == 0) Pt[(ai * HALF + wr * 64 + m * 16 + fr) * 4 + wc] = q;
            }
        }
        asm volatile("s_waitcnt lgkmcnt(0)" ::: "memory"); __builtin_amdgcn_s_barrier(); asm volatile("" ::: "memory");
        const int row = wid * 32 + (lane & 31);
        if (lane < 32) { const f32x4 p = *(const PG8_LAS f32x4*)(Pt + row * 4);
            __hip_atomic_store(xbuf + (size_t)(u.pm * BM + row) * 4 + u.pn, __builtin_bit_cast(unsigned, (p[0] + p[1]) + (p[2] + p[3])), __ATOMIC_RELAXED, __HIP_MEMORY_SCOPE_AGENT); }
        asm volatile("s_waitcnt vmcnt(0)" ::: "memory");
        if (lane == 0) __hip_atomic_fetch_add(cnt + 64 * u.pm, 1u, __ATOMIC_RELAXED, __HIP_MEMORY_SCOPE_AGENT);
        if (wid == 0) {
            unsigned spins = 0u;
            while ((unsigned)__builtin_amdgcn_readfirstlane(__hip_atomic_load(cnt + 64 * u.pm, __ATOMIC_RELAXED, __HIP_MEMORY_SCOPE_AGENT)) < 32u) { __builtin_amdgcn_s_sleep(2); if (++spins > (1u << 22)) break; }
            __builtin_amdgcn_fence(__ATOMIC_ACQUIRE, "agent");
        }
        asm volatile("s_waitcnt vmcnt(0) lgkmcnt(0)" ::: "memory"); __builtin_amdgcn_s_barrier(); asm volatile("" ::: "memory");
        if (lane < 32) { const unsigned* slot = xbuf + (size_t)(u.pm * BM + row) * 4; float t = 0.f;
#pragma unroll
            for (int k = 0; k < 4; ++k) t += __builtin_bit_cast(float, __hip_atomic_load(slot + k, __ATOMIC_RELAXED, __HIP_MEMORY_SCOPE_AGENT));
            Sr[row] = __builtin_amdgcn_rsqf(t * (1.0f / (float)DM) + RMS_EPS); }
        asm volatile("s_waitcnt lgkmcnt(0)" ::: "memory"); __builtin_amdgcn_s_barrier(); asm volatile("" ::: "memory");
#pragma unroll
        for (int ai = 0; ai < 2; ++ai)
#pragma unroll
            for (int m = 0; m < 4; ++m) { const float rs = Sr[ai * HALF + wr * 64 + m * 16 + fr];
#pragma unroll
                for (int bj = 0; bj < 2; ++bj) { const size_t off = (size_t)(row0 + ai * HALF + m * 16) * DM + col0 + bj * HALF;
                    *(f32x4*)(out + off) = acc[ai][bj][m][0] * rs * gv[bj][0]; *(f32x4*)(out + off + 4) = acc[ai][bj][m][1] * rs * gv[bj][1]; } }
    }
};
struct EpiWin {
    static constexpr bool PERM = true, AFTER_DRAIN = false;
    bf16_t *Q, *V; const float* ssq; const float* ropec; const float* ropes;
    __device__ __forceinline__ void operator()(const f32x4 (&acc)[2][2][4][2], const Unit& u, int wr, int wc, int fr, int fq) const {
        const int row0 = u.pm * BM + wr * 64 + fr, pn = u.pn;
        float rsv[2][4]; rows_rstd(ssq, row0, fq, rsv);
        if (pn < 2) {
            const int i0 = 16 * (wc & 1) + 4 * fq; const float qs = pn == 0 ? 0.125f : 1.0f;
#pragma unroll
            for (int ai = 0; ai < 2; ++ai) {
                f32x4 cc[4], ss[4];
#pragma unroll
                for (int m = 0; m < 4; ++m) { const int pos = (row0 + ai * HALF + m * 16) & 2047; cc[m] = *(const f32x4*)(ropec + pos * 32 + i0); ss[m] = *(const f32x4*)(ropes + pos * 32 + i0); }
#pragma unroll
                for (int m = 0; m < 4; ++m) {
                    const int row = row0 + ai * HALF + m * 16; const float sc = qs * rsv[ai][m];
                    bf16_t* dst = Q + (size_t)pn * (16u << 20) + (size_t)row * 256;
#pragma unroll
                    for (int bj = 0; bj < 2; ++bj) {
                        const int head = 2 * bj + (wc >> 1);
                        const f32x4 x1 = acc[ai][bj][m][0] * sc, x2 = acc[ai][bj][m][1] * sc;
                        const f32x4 o1 = x1 * cc[m] - x2 * ss[m], o2 = x1 * ss[m] + x2 * cc[m];
                        u32x2 w1, w2; w1.x = cvt_pk_bf16(o1[0], o1[1]); w1.y = cvt_pk_bf16(o1[2], o1[3]); w2.x = cvt_pk_bf16(o2[0], o2[1]); w2.y = cvt_pk_bf16(o2[2], o2[3]);
                        *(u32x2*)(dst + head * 64 + i0) = w1; *(u32x2*)(dst + head * 64 + 32 + i0) = w2;
                    }
                }
            }
        } else {
            const bool act = (pn == 4 || pn == 5);
#pragma unroll
            for (int ai = 0; ai < 2; ++ai)
#pragma unroll
                for (int m = 0; m < 4; ++m) {
                    const int row = row0 + ai * HALF + m * 16; const float rs = rsv[ai][m];
                    bf16_t* dst = V + (size_t)((pn - 2) >> 1) * (32u << 20) + (size_t)row * 512 + (pn & 1) * 256 + wc * 32 + 8 * fq;
#pragma unroll
                    for (int bj = 0; bj < 2; ++bj) {
                        f32x4 v0 = acc[ai][bj][m][0] * rs, v1 = acc[ai][bj][m][1] * rs;
                        if (act) { v0 = silu4(v0); v1 = silu4(v1); }
                        u32x4 w; w.x = cvt_pk_bf16(v0[0], v0[1]); w.y = cvt_pk_bf16(v0[2], v0[3]); w.z = cvt_pk_bf16(v1[0], v1[1]); w.w = cvt_pk_bf16(v1[2], v1[3]);
                        *(u32x4*)(dst + bj * HALF) = w;
                    }
                }
        }
    }
};

template <class Epi, class Sched, bool ALIGN_EPI = false, bool SP2 = false, bool ATILED = false>
__device__ __forceinline__ void gemm_phase(PG8_LAS unsigned char* lds, const Gemm g, const Sched& S, const Epi& E) {
    const int tid = threadIdx.x, wid = __builtin_amdgcn_readfirstlane(tid >> 6), lane = tid & 63, wr = wid >> 2, wc = wid & 3, fr = lane & 15, fq = lane >> 4;
    const int K = g.K, nt = K / BK;
    unsigned voffA[2], voffB[2];
#pragma unroll
    for (int i = 0; i < 2; ++i) { int R, C; stage_rc(tid * 16 + i * 8192, R, C); const int Rb = Epi::PERM ? ((R & ~31) + perm32(R & 31)) : R;
        voffA[i] = (unsigned)(R * (ATILED ? BK : K) + C) * 2u; voffB[i] = (unsigned)(Rb * K + C) * 2u; }
    const size_t kstep = (size_t)(BK * 2);
    const size_t hstep = (size_t)HALF * K * 2;
    const size_t tstep = 2 * hstep;
    const size_t kstepA = ATILED ? (size_t)(BM * BK * 2) : kstep, hstepA = ATILED ? (size_t)(HALF * BK * 2) : hstep, tstepA = ATILED ? (size_t)nt * (BM * BK * 2) : tstep;
    const unsigned ldsw = (unsigned)wid * 1024u;
    const int aoff = lds_byte(wr * 64 + fr, fq * 8), boff = lds_byte(wc * 32 + fr, fq * 8);
#define PG8_SA(b, h) (((b) * 2 + (h)) * HTB)
#define PG8_SB(b, h) ((4 + (b) * 2 + (h)) * HTB)
#define PG8_STAGE(bufoff, gbase, voff) do { _Pragma("unroll") for (int _i = 0; _i < 2; ++_i) \
        __builtin_amdgcn_global_load_lds((const unsigned*)((const char*)(gbase) + (voff)[_i]), (PG8_LAS unsigned*)(lds + (bufoff) + ldsw + _i * 8192), 16, 0, 0); } while (0)
#define PG8_LDA(dst, b, h) do { _Pragma("unroll") for (int m = 0; m < 4; ++m) _Pragma("unroll") for (int k = 0; k < 2; ++k) dst[m][k] = *(const PG8_LAS bf16x8*)(lds + PG8_SA(b, h) + aoff + m * 2048 + k * 1024); } while (0)
#define PG8_LDB(dst, b, h) do { _Pragma("unroll") for (int n = 0; n < 2; ++n) _Pragma("unroll") for (int k = 0; k < 2; ++k) dst[n][k] = *(const PG8_LAS bf16x8*)(lds + PG8_SB(b, h) + boff + n * 2048 + k * 1024); } while (0)
#define PG8_MMA(ai, bj, At, Bt) do { __builtin_amdgcn_s_setprio(1); _Pragma("unroll") for (int m = 0; m < 4; ++m) _Pragma("unroll") for (int n = 0; n < 2; ++n) _Pragma("unroll") for (int k = 0; k < 2; ++k) \
        acc[ai][bj][m][n] = __builtin_amdgcn_mfma_f32_16x16x32_bf16(Bt[n][k], At[m][k], acc[ai][bj][m][n], 0, 0, 0); __builtin_amdgcn_s_setprio(0); } while (0)
#define PG8_WAIT_V(n) asm volatile("s_waitcnt vmcnt(" #n ")" ::: "memory")
#define PG8_WAIT_L(n) asm volatile("s_waitcnt lgkmcnt(" #n ")" ::: "memory")
#define PG8_BAR __builtin_amdgcn_s_barrier()
#define PG8_SCHED __builtin_amdgcn_sched_barrier(0)
    Unit cur, nxt; int ui = 0;
    if (!S.next(0, cur)) return;
    f32x4 acc[2][2][4][2];
#pragma unroll
    for (int a = 0; a < 2; ++a)
#pragma unroll
        for (int b = 0; b < 2; ++b)
#pragma unroll
            for (int m = 0; m < 4; ++m)
#pragma unroll
                for (int n = 0; n < 2; ++n) acc[a][b][m][n] = (f32x4){0.f, 0.f, 0.f, 0.f};
    bf16x8 At[4][2], B0[2][2], B1[2][2];
    const char* cA = (const char*)g.A + (size_t)cur.pm * tstepA; const char* cB = (const char*)g.Bt + (size_t)cur.pn * tstep;
    S.a_ready(cur);
    if constexpr (SP2) {
        PG8_STAGE(PG8_SB(0, 0), cB, voffB); PG8_STAGE(PG8_SB(0, 1), cB + hstep, voffB); PG8_STAGE(PG8_SA(0, 0), cA, voffA); PG8_STAGE(PG8_SA(0, 1), cA + hstepA, voffA);
        if (wr == 1) PG8_BAR;
        PG8_WAIT_V(2); PG8_BAR;
        PG8_STAGE(PG8_SB(1, 0), cB + kstep, voffB); PG8_STAGE(PG8_SA(1, 0), cA + kstepA, voffA); PG8_STAGE(PG8_SB(1, 1), cB + hstep + kstep, voffB);
        PG8_WAIT_V(6); PG8_BAR;
    } else {
        PG8_STAGE(PG8_SB(0, 0), cB, voffB); PG8_STAGE(PG8_SA(0, 0), cA, voffA); PG8_STAGE(PG8_SB(0, 1), cB + hstep, voffB); PG8_STAGE(PG8_SA(0, 1), cA + hstepA, voffA);
        if (wr == 1) PG8_BAR;
        PG8_WAIT_V(4); PG8_BAR;
        PG8_STAGE(PG8_SB(1, 0), cB + kstep, voffB); PG8_STAGE(PG8_SA(1, 0), cA + kstepA, voffA); PG8_STAGE(PG8_SB(1, 1), cB + hstep + kstep, voffB);
        PG8_WAIT_V(6); PG8_BAR;
    }
    for (;;) {
        const bool has_next = S.next(ui + 1, nxt);
        const char* nA = has_next ? (const char*)g.A + (size_t)nxt.pm * tstepA : cA; const char* nB = has_next ? (const char*)g.Bt + (size_t)nxt.pn * tstep : cB;
        for (int t = 0; t < nt; t += 2) {
            const bool last = (t == nt - 2);
            const char* a1 = cA + (size_t)(t + 1) * kstepA;
            const char* a2 = last ? nA : cA + (size_t)(t + 2) * kstepA; const char* b2 = last ? nB : cB + (size_t)(t + 2) * kstep;
            const char* a3 = a2 + kstepA; const char* b3 = b2 + kstep;
            if (last && has_next) S.a_ready(nxt);
            if constexpr (SP2) {
            PG8_LDB(B0, 0, 0); PG8_LDB(B1, 0, 1); PG8_SCHED; PG8_LDA(At, 0, 0); PG8_STAGE(PG8_SA(1, 1), a1 + hstepA, voffA);
            PG8_WAIT_V(8); PG8_WAIT_L(0); PG8_BAR; PG8_MMA(0, 0, At, B0); PG8_MMA(0, 1, At, B1); PG8_BAR; PG8_SCHED;
            PG8_LDA(At, 0, 1); PG8_STAGE(PG8_SB(0, 0), b2, voffB); PG8_STAGE(PG8_SB(0, 1), b2 + hstep, voffB); PG8_STAGE(PG8_SA(0, 0), a2, voffA);
            PG8_WAIT_V(8); PG8_WAIT_L(0); PG8_BAR; PG8_MMA(1, 0, At, B0); PG8_MMA(1, 1, At, B1); PG8_BAR; PG8_SCHED;
            PG8_LDB(B0, 1, 0); PG8_LDB(B1, 1, 1); PG8_SCHED; PG8_LDA(At, 1, 0); PG8_STAGE(PG8_SA(0, 1), a2 + hstepA, voffA);
            PG8_WAIT_V(8); PG8_WAIT_L(0); PG8_BAR; PG8_MMA(0, 0, At, B0); PG8_MMA(0, 1, At, B1); PG8_BAR; PG8_SCHED;
            PG8_LDA(At, 1, 1); PG8_STAGE(PG8_SB(1, 0), b3, voffB); PG8_STAGE(PG8_SB(1, 1), b3 + hstep, voffB); PG8_STAGE(PG8_SA(1, 0), a3, voffA);
            PG8_WAIT_V(8); PG8_WAIT_L(0); PG8_BAR; PG8_MMA(1, 0, At, B0); PG8_MMA(1, 1, At, B1); PG8_BAR; PG8_SCHED;
            } else {
            PG8_LDB(B0, 0, 0); PG8_SCHED; PG8_LDA(At, 0, 0); PG8_STAGE(PG8_SA(1, 1), a1 + hstepA, voffA);
            PG8_WAIT_L(8); PG8_BAR; PG8_WAIT_L(0); PG8_MMA(0, 0, At, B0); PG8_BAR; PG8_SCHED;
            PG8_LDB(B1, 0, 1); PG8_STAGE(PG8_SB(0, 0), b2, voffB);
            PG8_BAR; PG8_WAIT_L(0); PG8_MMA(0, 1, At, B1); PG8_BAR;
            PG8_LDA(At, 0, 1); PG8_STAGE(PG8_SA(0, 0), a2, voffA);
            PG8_BAR; PG8_WAIT_L(0); PG8_MMA(1, 0, At, B0); PG8_BAR; PG8_SCHED;
            PG8_STAGE(PG8_SB(0, 1), b2 + hstep, voffB);
            PG8_WAIT_V(6); PG8_BAR; PG8_MMA(1, 1, At, B1); PG8_BAR;
            PG8_LDB(B0, 1, 0); PG8_SCHED; PG8_LDA(At, 1, 0); PG8_STAGE(PG8_SA(0, 1), a2 + hstepA, voffA);
            PG8_WAIT_L(8); PG8_BAR; PG8_WAIT_L(0); PG8_MMA(0, 0, At, B0); PG8_BAR; PG8_SCHED;
            PG8_LDB(B1, 1, 1); PG8_STAGE(PG8_SB(1, 0), b3, voffB);
            PG8_BAR; PG8_WAIT_L(0); PG8_MMA(0, 1, At, B1); PG8_BAR;
            PG8_LDA(At, 1, 1); PG8_STAGE(PG8_SA(1, 0), a3, voffA);
            PG8_BAR; PG8_WAIT_L(0); PG8_MMA(1, 0, At, B0); PG8_BAR; PG8_SCHED;
            PG8_STAGE(PG8_SB(1, 1), b3 + hstep, voffB);
            PG8_WAIT_V(6); PG8_BAR; PG8_MMA(1, 1, At, B1); PG8_BAR;
            }
        }
        if constexpr (ALIGN_EPI) { if (wr == 0) PG8_BAR; }
        if constexpr (!Epi::AFTER_DRAIN) { E(acc, cur, wr, wc, fr, fq); S.done(cur); }
        if (!has_next) break;
#pragma unroll
        for (int a = 0; a < 2; ++a)
#pragma unroll
            for (int b = 0; b < 2; ++b)
#pragma unroll
                for (int m = 0; m < 4; ++m)
#pragma unroll
                    for (int n = 0; n < 2; ++n) acc[a][b][m][n] = (f32x4){0.f, 0.f, 0.f, 0.f};
        cur = nxt; cA = nA; cB = nB; ++ui;
        if constexpr (ALIGN_EPI) { if (wr == 1) PG8_BAR; }
    }
    PG8_WAIT_V(0);
    if constexpr (!ALIGN_EPI) { if (wr == 0) PG8_BAR; }
    PG8_BAR;
    if constexpr (Epi::AFTER_DRAIN) { E.fused(acc, cur, wr, wc, fr, fq, lds, wid, lane); S.done(cur); }
#undef PG8_SA
#undef PG8_SB
#undef PG8_STAGE
#undef PG8_LDA
#undef PG8_LDB
#undef PG8_MMA
#undef PG8_WAIT_V
#undef PG8_WAIT_L
#undef PG8_BAR
#undef PG8_SCHED
}
}

constexpr int NWAVES = 8, NTHREADS = 512;
constexpr int BATCH = 32, SEQ = 2048, D = 1024, FF = 2816, NGU = 2 * FF, INW = 2048, M = BATCH * SEQ;
constexpr int NPHASE = 8;
#define MK_SANITIZE 0
#ifndef MK_REPEAT_MASK
#define MK_REPEAT_MASK 0
#endif
#define REP(k) for (int rep_ = 0; rep_ <= ((MK_REPEAT_MASK >> (k)) & 1); ++rep_)
#define MK_SKIP_MASK 0
#define MK_NO_RET 0
#define MK_NO_POOL 0
#define MK_POOL_FROM_XB 0
#ifndef MK_N_LAUNCHES
#define MK_N_LAUNCHES 1
#endif
constexpr size_t MiB = 1u << 20;
constexpr size_t WS_XB = 0;
constexpr size_t WS_BIG = 128 * MiB;
constexpr size_t WS_Q = WS_BIG, WS_K = WS_Q + 32 * MiB, WS_V = WS_K + 32 * MiB, WS_SG = WS_V + 64 * MiB, WS_U = WS_SG + 64 * MiB, WS_RS = WS_U + 64 * MiB;
constexpr size_t WS_W = 512 * MiB;
constexpr size_t WS_WGU1 = WS_W, WS_WD1 = WS_WGU1 + (size_t)NGU * D * 2, WS_WGU2 = WS_WD1 + (size_t)D * FF * 2, WS_WD2 = WS_WGU2 + (size_t)NGU * D * 2;
constexpr size_t WS_WIN = WS_WD2 + (size_t)D * FF * 2, WS_WOUT = WS_WIN + (size_t)INW * D * 2, WS_WP = WS_WOUT + (size_t)D * D * 2;
constexpr size_t WS_SSQ = 576 * MiB;
constexpr size_t WS_ROPEC = 584 * MiB, WS_ROPES = WS_ROPEC + 2048 * 32 * 4;
constexpr size_t WS_CTL = 592 * MiB, CTL_BYTES = 131072, CTL_CNT = 65536;
constexpr size_t WS_XBUF = 593 * MiB;
constexpr size_t WS_END = 595 * MiB;
static_assert(WS_K == WS_Q + 32 * MiB && WS_SG == WS_V + 64 * MiB && WS_U == WS_V + 128 * MiB, "EpiWin pointer arithmetic");
static_assert(WS_RS + (size_t)M * D * 2 <= WS_W && WS_BIG + (size_t)M * FF * 2 <= WS_W && WS_WP + 4 * 128 * 128 * 2 <= WS_SSQ, "d_ws map");
constexpr int LDS_BYTES = 147456, LDS_BARST = 147456 - 64;

#define LAS __attribute__((address_space(3)))
typedef unsigned short bf16;
typedef unsigned v4u __attribute__((ext_vector_type(4)));
typedef unsigned v2u __attribute__((ext_vector_type(2)));
typedef float f32x4 __attribute__((ext_vector_type(4)));
typedef short bf16x8 __attribute__((ext_vector_type(8)));
#define LBAR() do { asm volatile("s_waitcnt lgkmcnt(0)" ::: "memory"); __builtin_amdgcn_s_barrier(); asm volatile("" ::: "memory"); } while (0)
__device__ __forceinline__ unsigned f2bf(float f) { return (unsigned)__builtin_bit_cast(unsigned short, (__bf16)f); }
__device__ __forceinline__ unsigned pk2(float lo, float hi) { return pg8::cvt_pk_bf16(lo, hi); }
__device__ __forceinline__ float bflo(unsigned w) { return __builtin_bit_cast(float, w << 16); }
__device__ __forceinline__ float bfhi(unsigned w) { return __builtin_bit_cast(float, w & 0xffff0000u); }
__device__ __forceinline__ float bf2f(unsigned short h) { return __builtin_bit_cast(float, (unsigned)h << 16); }
__device__ __forceinline__ float wave_sum(float v) {
#pragma unroll
    for (int o = 1; o < 64; o <<= 1) v += __shfl_xor(v, o);
    return v;
}
__device__ __forceinline__ f32x4 mfma16(bf16x8 a, bf16x8 b, f32x4 c) { return __builtin_amdgcn_mfma_f32_16x16x32_bf16(a, b, c, 0, 0, 0); }

__device__ const float ROPE_FREQ[32] = {
    1.000000000e+00f, 7.498942614e-01f, 5.623413324e-01f, 4.216965139e-01f, 3.162277639e-01f, 2.371373773e-01f, 1.778279394e-01f, 1.333521307e-01f,
    1.000000015e-01f, 7.498941571e-02f, 5.623413250e-02f, 4.216965288e-02f, 3.162277490e-02f, 2.371373773e-02f, 1.778279431e-02f, 1.333521493e-02f,
    9.999999776e-03f, 7.498941850e-03f, 5.623413250e-03f, 4.216964822e-03f, 3.162277630e-03f, 2.371373586e-03f, 1.778279431e-03f, 1.333521446e-03f,
    1.000000047e-03f, 7.498942432e-04f, 5.623413017e-04f, 4.216965172e-04f, 3.162277571e-04f, 2.371373703e-04f, 1.778279402e-04f, 1.333521504e-04f};

#define RLX_AGENT __ATOMIC_RELAXED, __HIP_MEMORY_SCOPE_AGENT
#define XB_TMO      128
#define XB_XCNT(j)  (256  + 64 * (j))
#define XB_XSUB(j)  (1280 + 64 * (j))
#define XB_XGEN(j)  (2304 + 64 * (j))
#define XB_TOP      3328
#define XB_TOPGEN   3392
#define XCD_BAR_WORDS 3456
#define XB_SPIN_CAP (1u << 18)

__device__ __forceinline__ unsigned xb_ld(unsigned* p)              { return __hip_atomic_load(p, __ATOMIC_RELAXED, __HIP_MEMORY_SCOPE_AGENT); }
__device__ __forceinline__ unsigned xb_add(unsigned* p, unsigned v) { return __hip_atomic_fetch_add(p, v, __ATOMIC_RELAXED, __HIP_MEMORY_SCOPE_AGENT); }
__device__ __forceinline__ unsigned xb_xcc_id() { return (unsigned)__builtin_amdgcn_s_getreg((3 << 11) | 20) & 0xFu; }
#define XB_SPIN(cond, bar) do { unsigned _sp = 0; while (cond) { __builtin_amdgcn_s_sleep(1); \
    if ((++_sp & 255u) == 0u) { if (xb_ld(&(bar)[XB_TMO])) break; if (_sp > XB_SPIN_CAP) { atomicAdd(&(bar)[XB_TMO], 1u); break; } } } } while (0)

struct XcdBarrier {
    unsigned* bar; unsigned x;
    volatile LAS unsigned* st;
};

__device__ __forceinline__ XcdBarrier xcd_barrier_post(unsigned* bar, volatile LAS unsigned* st) {
    XcdBarrier b; b.bar = bar; b.x = xb_xcc_id(); b.st = st;
    if (threadIdx.x == 0) (void)xb_add(&bar[XB_XCNT(b.x)], 1u);
    return b;
}
__device__ __forceinline__ void xcd_barrier_complete(unsigned* bar, unsigned x, unsigned& nloc, unsigned& nx) {
    const unsigned G = gridDim.x * gridDim.y * gridDim.z;
    unsigned sum, cnt, mine, sp = 0u;
    for (;;) {
        sum = 0u; cnt = 0u; mine = 0u;
#pragma unroll
        for (unsigned j = 0; j < 16; ++j) { const unsigned c = xb_ld(&bar[XB_XCNT(j)]); sum += c; cnt += (c > 0u) ? 1u : 0u; mine = (j == x) ? c : mine; }
        if (sum == G) break;
        __builtin_amdgcn_s_sleep(1);
        if ((++sp & 255u) == 0u) { if (xb_ld(&bar[XB_TMO])) break; if (sp > XB_SPIN_CAP) { atomicAdd(&bar[XB_TMO], 1u); break; } }
    }
    nloc = mine > 0u ? mine : 1u; nx = cnt > 0u ? cnt : 1u;
}

__device__ __forceinline__ void xcd_barrier(const XcdBarrier& b) {
    asm volatile("s_waitcnt vmcnt(0)" ::: "memory");
    __syncthreads();
    if (threadIdx.x == 0) {
        unsigned* bar = b.bar;
        __builtin_amdgcn_s_waitcnt(0);
        unsigned nloc = b.st[0], nx = b.st[1];
        if (nloc == 0u) { xcd_barrier_complete(bar, b.x, nloc, nx); b.st[0] = nloc; b.st[1] = nx; }
        const unsigned old = xb_add(&bar[XB_XSUB(b.x)], 1u);
        const unsigned gen = old / nloc;
        if (old + 1u == (gen + 1u) * nloc) {
            __builtin_amdgcn_fence(__ATOMIC_RELEASE, "agent");
            asm volatile("s_waitcnt vmcnt(0)" ::: "memory");
            const unsigned og = xb_add(&bar[XB_TOP], 1u);
            const unsigned tg = og / nx;
            if (og + 1u == (tg + 1u) * nx) xb_add(&bar[XB_TOPGEN], 1u);
            else XB_SPIN(xb_ld(&bar[XB_TOPGEN]) == tg, bar);
            __builtin_amdgcn_fence(__ATOMIC_ACQUIRE, "agent");
            xb_add(&bar[XB_XGEN(b.x)], 1u);
            asm volatile("s_waitcnt vmcnt(0)" ::: "memory");
        } else {
            XB_SPIN(xb_ld(&bar[XB_XGEN(b.x)]) == gen, bar);
            __builtin_amdgcn_fence(__ATOMIC_ACQUIRE, "agent");
            asm volatile("s_waitcnt vmcnt(0)" ::: "memory");
        }
    }
    __syncthreads();
}

__device__ __forceinline__ int wrow(int kind, int n) {
    if (kind == 0) return n;
    if (kind == 1) return 256 * (n >> 7) + (n & 127);
    if (kind == 2) return 256 * (n >> 7) + 128 + (n & 127);
    if (n >= 512) return n;
    const int base = n & ~255, o = n & 255, head = o >> 6, r = o & 63, nn = r >> 5, i = r & 31;
    const int bj = head >> 1, wc = 2 * (head & 1) + (i >> 4), fq = (i & 15) >> 2, e = i & 3;
    return base + 128 * bj + 32 * wc + 8 * fq + 4 * nn + e;
}
__device__ __forceinline__ void p0_transpose_item(const float* W, int K, int N, bf16* WT, int kind, const float* gain, LAS float* scr, int item, int lane) {
    const int nblk = N / 32, kb = item / nblk, nb = item % nblk, k0 = 64 * kb, n0 = 32 * nb;
    float wv[32];
#pragma unroll
    for (int i = 0; i < 32; ++i) wv[i] = W[(size_t)(k0 + 2 * i + (lane >> 5)) * N + n0 + (lane & 31)];
    if (gain) {
#pragma unroll
        for (int i = 0; i < 32; ++i) wv[i] *= gain[k0 + 2 * i + (lane >> 5)];
    }
#pragma unroll
    for (int i = 0; i < 32; ++i) scr[(2 * i + (lane >> 5)) * 33 + (lane & 31)] = wv[i];
    asm volatile("s_waitcnt lgkmcnt(0)" ::: "memory");
    const int c = lane & 7;
#pragma unroll
    for (int j = 0; j < 4; ++j) { const int n = (lane >> 3) + 8 * j; const LAS float* s = scr + (8 * c) * 33 + n;
        v4u o; o.x = pk2(s[0 * 33], s[1 * 33]); o.y = pk2(s[2 * 33], s[3 * 33]); o.z = pk2(s[4 * 33], s[5 * 33]); o.w = pk2(s[6 * 33], s[7 * 33]);
        *(v4u*)(WT + (size_t)wrow(kind, n0 + n) * K + k0 + 8 * c) = o; }
    asm volatile("s_waitcnt lgkmcnt(0)" ::: "memory");
}

struct Ptrs {
    const float *x, *n1, *g1, *u1, *d1, *nm, *win, *gng, *pw, *ps, *wout, *n2, *g2, *u2, *d2, *nf;
    float* out;
    bf16 *XB, *ACT, *Q, *K, *V, *SG, *U, *RS, *WGU1, *WD1, *WGU2, *WD2, *WIN, *WOUT, *WP;
    float *SSQ, *ROPEC, *ROPES;
};

__device__ __forceinline__ void p0_prologue(const Ptrs& P, LAS unsigned char* lds, int tid, int lane, int wave) {
    LAS float* scr = (LAS float*)(lds + wave * 16384);
    const int gw = blockIdx.x * NWAVES + wave, NGW = gridDim.x * NWAVES;
    constexpr int I_GU = (D / 64) * (FF / 32), I_DN = (FF / 64) * (D / 32), I_IN = (D / 64) * (INW / 32);
    constexpr int NITEMS = 2 * I_GU + I_DN + I_IN;
    for (int it = gw; it < NITEMS; it += NGW) {
        int r = it;
        if (r < I_GU) { p0_transpose_item(P.g1, D, FF, P.WGU1, 1, P.n1, scr, r, lane); continue; } r -= I_GU;
        if (r < I_GU) { p0_transpose_item(P.u1, D, FF, P.WGU1, 2, P.n1, scr, r, lane); continue; } r -= I_GU;
        if (r < I_DN) { p0_transpose_item(P.d1, FF, D, P.WD1, 0, nullptr, scr, r, lane); continue; } r -= I_DN;
        p0_transpose_item(P.win, D, INW, P.WIN, 3, P.nm, scr, r, lane);
    }
    const int gt = blockIdx.x * NTHREADS + tid, NGT = gridDim.x * NTHREADS;
    for (int i = gt; i < 4 * 128 * 128; i += NGT) { const int g = i >> 14, d = (i >> 7) & 127, c = i & 127; P.WP[i] = (bf16)f2bf(P.pw[(g * 128 + c) * 128 + d] * P.ps[g * 128 + d]); }
    for (int i = gt; i < 2048 * 32; i += NGT) { const int pos = i >> 5; const float ang = (float)pos * ROPE_FREQ[i & 31];
        double rev = (double)ang * 0.15915494309189535; rev -= __builtin_floor(rev); const float rf = (float)rev;
        P.ROPEC[i] = __builtin_amdgcn_cosf(rf); P.ROPES[i] = __builtin_amdgcn_sinf(rf); }
    constexpr int XR = 8;
    for (int m = XR * gw; m < M; m += XR * NGW) {
        const f32x4* xr = (const f32x4*)(P.x + (size_t)m * D) + lane; f32x4 v[XR][4];
#pragma unroll
        for (int r = 0; r < XR; ++r)
#pragma unroll
            for (int j = 0; j < 4; ++j) v[r][j] = __builtin_nontemporal_load(xr + r * (D / 4) + 64 * j);
#pragma unroll
        for (int r = 0; r < XR; ++r) {
            float s = 0.f;
#pragma unroll
            for (int j = 0; j < 4; ++j) s += (v[r][j][0] * v[r][j][0] + v[r][j][1] * v[r][j][1]) + (v[r][j][2] * v[r][j][2] + v[r][j][3] * v[r][j][3]);
            s = wave_sum(s);
            v2u* o8 = (v2u*)(P.XB + (size_t)(m + r) * D) + lane;
#pragma unroll
            for (int j = 0; j < 4; ++j) { v2u w; w.x = pk2(v[r][j][0], v[r][j][1]); w.y = pk2(v[r][j][2], v[r][j][3]); o8[64 * j] = w; }
            if (lane < 16) P.SSQ[(size_t)(m + r) * 16 + lane] = lane == 0 ? s : 0.f;
        }
    }
}

__device__ __forceinline__ void late_weights(const Ptrs& P, LAS unsigned char* lds, int wblk, int nwblk, int lane, int wave) {
    LAS float* scr = (LAS float*)(lds + wave * 16384);
    const int gw = wblk * NWAVES + wave, NGW = nwblk * NWAVES;
    constexpr int I_GU = (D / 64) * (FF / 32), I_DN = (FF / 64) * (D / 32), I_OUT = (D / 64) * (D / 32);
    constexpr int NITEMS = I_OUT + 2 * I_GU + I_DN;
    for (int it = gw; it < NITEMS; it += NGW) {
        int r = it;
        if (r < I_OUT) { p0_transpose_item(P.wout, D, D, P.WOUT, 0, nullptr, scr, r, lane); continue; } r -= I_OUT;
        if (r < I_GU) { p0_transpose_item(P.g2, D, FF, P.WGU2, 1, P.n2, scr, r, lane); continue; } r -= I_GU;
        if (r < I_GU) { p0_transpose_item(P.u2, D, FF, P.WGU2, 2, P.n2, scr, r, lane); continue; } r -= I_GU;
        p0_transpose_item(P.d2, FF, D, P.WD2, 0, nullptr, scr, r, lane);
    }
}

namespace mix {
constexpr int S72 = 72, S136 = 136, S144 = 144;
constexpr int OFF_Q = 0, OFF_K = 9216, OFF_K2 = 18432, OFF_V = 27648, OFF_S = 46080, OFF_ST = 55296, OFF_SG = 73728, OFF_O = 91136, OFF_PART = 108544, OFF_STAT = 124928;
__device__ const float LG2[4] = {-0.04580368961312479f, -0.02272007650008353f, -0.011315313227834146f, -0.005646563141142063f};
__device__ __forceinline__ float ex2(float x) { return __builtin_amdgcn_exp2f(x); }
typedef short s16x4 __attribute__((ext_vector_type(4)));
__device__ __forceinline__ bf16x8 tr_frag(LAS unsigned char* img, int pitch, int c, int ks, int fq, int fr) {
    LAS unsigned char* a0 = img + (32 * ks + 8 * fq + (fr >> 2)) * pitch + 32 * c + 8 * (fr & 3);
    const s16x4 lo = __builtin_amdgcn_ds_read_tr16_b64_v4i16((LAS s16x4*)a0), hi = __builtin_amdgcn_ds_read_tr16_b64_v4i16((LAS s16x4*)(a0 + 4 * pitch));
    return __builtin_shufflevector(lo, hi, 0, 1, 2, 3, 4, 5, 6, 7);
}

constexpr int RSET = 46080, ROFF_Q = 0, ROFF_K = 9216, ROFF_K2 = 18432, ROFF_V = 27648, ROFF_S = 92160, ROFF_ST = 101376, ROFF_PART = 119808, ROFF_STAT = 136192;
__device__ __forceinline__ void retention_unit(LAS unsigned char* lds, const Ptrs& P, int b, int h, int tid) {
    const int lane = tid & 63, w = __builtin_amdgcn_readfirstlane(tid >> 6), fr = lane & 15, fq = lane >> 4;
    const float lg = LG2[h];
    LAS bf16* Ss = (LAS bf16*)(lds + ROFF_S); LAS bf16* St = (LAS bf16*)(lds + ROFF_ST);
    LAS float* part = (LAS float*)(lds + ROFF_PART); LAS float* stat = (LAS float*)(lds + ROFF_STAT);
    for (int i = tid; i < 128 * S72 * 2 / 16; i += NTHREADS) ((LAS v4u*)St)[i] = (v4u){0u, 0u, 0u, 0u};
    f32x4 st[4];
#pragma unroll
    for (int i = 0; i < 4; ++i) st[i] = (f32x4){0.f, 0.f, 0.f, 0.f};
    const int lrow = tid >> 3, lseg = tid & 7, vrow0 = tid >> 4, vseg = tid & 15;
    const size_t tok0 = (size_t)b * SEQ;
    const bf16* gq = P.Q + (tok0 + lrow) * 256 + h * 64 + lseg * 8; const bf16* gk = P.K + (tok0 + lrow) * 256 + h * 64 + lseg * 8;
    const bf16* gv = P.V + (tok0 + vrow0) * 512 + h * 128 + vseg * 8;
    const bf16* gsl = P.SG + (tok0 + fr) * 512 + h * 128 + 16 * w + 4 * fq;
    bf16* gol = P.RS + (tok0 + fr) * 1024 + h * 128 + 16 * w + 4 * fq;
    v4u rq = *(const v4u*)gq, rk = *(const v4u*)gk, rv0 = *(const v4u*)gv, rv1 = *(const v4u*)(gv + 32 * 512);
    const float dkey = ex2((float)(63 - lrow) * lg), dch = ex2(64.f * lg);
    const f32x4 gng4 = *(const f32x4*)(P.gng + h * 128 + 16 * w + 4 * fq);
    const int it3 = w >> 1;
    float dqv[4]; f32x4 decv[2];
#pragma unroll
    for (int it = 0; it < 4; ++it) dqv[it] = ex2((float)(16 * it + fr + 1) * lg);
#pragma unroll
    for (int j2 = 0; j2 < 2; ++j2)
#pragma unroll
        for (int r = 0; r < 4; ++r) decv[j2][r] = ex2(__builtin_fabsf((float)((16 * it3 + fr) - (16 * ((w & 1) * 2 + j2) + 4 * fq + r))) * lg);
    f32x4 op[4]; v2u sgr[4];
#pragma unroll
    for (int it = 0; it < 4; ++it) { op[it] = (f32x4){0.f, 0.f, 0.f, 0.f}; sgr[it] = (v2u){0u, 0u}; }
    for (int n = 0; n <= 32; ++n) {
        LAS unsigned char* bufc = lds + (n & 1) * RSET;
        LAS bf16* Qs = (LAS bf16*)(bufc + ROFF_Q); LAS bf16* Ks = (LAS bf16*)(bufc + ROFF_K); LAS bf16* K2s = (LAS bf16*)(bufc + ROFF_K2); LAS bf16* Vs = (LAS bf16*)(bufc + ROFF_V);
        if (n < 32) {
            *(LAS v4u*)(Qs + lrow * S72 + lseg * 8) = rq; *(LAS v4u*)(Ks + lrow * S72 + lseg * 8) = rk;
            v4u k2;
#pragma unroll
            for (int t = 0; t < 4; ++t) k2[t] = pk2(bflo(rk[t]) * dkey, bfhi(rk[t]) * dkey);
            *(LAS v4u*)(K2s + lrow * S72 + lseg * 8) = k2;
            *(LAS v4u*)(Vs + vrow0 * S144 + vseg * 8) = rv0; *(LAS v4u*)(Vs + (vrow0 + 32) * S144 + vseg * 8) = rv1;
        }
        if (n >= 1) {
#pragma unroll
            for (int it = 0; it < 4; ++it) sgr[it] = *(const v2u*)(gsl + ((size_t)(n - 1) * 64 + 16 * it) * 512);
        }
        LBAR();
        if (n + 1 < 32) { const size_t o4 = (size_t)(n + 1) * 64;
            rq = *(const v4u*)(gq + o4 * 256); rk = *(const v4u*)(gk + o4 * 256); rv0 = *(const v4u*)(gv + o4 * 512); rv1 = *(const v4u*)(gv + (o4 + 32) * 512); }
        if (n >= 1) {
            const int row = tid >> 3, sub = tid & 7;
            const f32x4 pa = *(const LAS f32x4*)(part + (row * 32 + sub * 4) * 2), pb = *(const LAS f32x4*)(part + (row * 32 + sub * 4) * 2 + 4);
            float s1 = (pa[0] + pa[2]) + (pb[0] + pb[2]), s2 = (pa[1] + pa[3]) + (pb[1] + pb[3]);
#pragma unroll
            for (int x = 1; x < 8; x <<= 1) { s1 += __shfl_xor(s1, x); s2 += __shfl_xor(s2, x); }
            if (sub == 0) { const float mean = s1 * (1.f / 128.f); float var = s2 * (1.f / 128.f) - mean * mean; var = var < 0.f ? 0.f : var;
                stat[row * 2] = mean; stat[row * 2 + 1] = __builtin_amdgcn_rsqf(var + 1e-5f); }
        }
        if (n < 32) {
#pragma unroll
            for (int j2 = 0; j2 < 2; ++j2) {
                const int jt = (w & 1) * 2 + j2; f32x4 a4 = (f32x4){0.f, 0.f, 0.f, 0.f};
#pragma unroll
                for (int ks = 0; ks < 2; ++ks) {
                    const bf16x8 qf = *(const LAS bf16x8*)(Qs + (16 * it3 + fr) * S72 + 32 * ks + 8 * fq), kf = *(const LAS bf16x8*)(Ks + (16 * jt + fr) * S72 + 32 * ks + 8 * fq);
                    a4 = mfma16(kf, qf, a4); }
                a4 = a4 * decv[j2];
                v2u pw; pw.x = pk2(a4[0], a4[1]); pw.y = pk2(a4[2], a4[3]);
                *(LAS v2u*)(Ss + (16 * it3 + fr) * S72 + 16 * jt + 4 * fq) = pw;
            }
        }
        LBAR();
        if (n >= 1) {
#pragma unroll
            for (int it = 0; it < 4; ++it) { const int i = 16 * it + fr; const float mean = stat[i * 2], rstd = stat[i * 2 + 1]; const v2u sg = sgr[it];
                const f32x4 y = (op[it] - mean) * rstd * gng4 * (f32x4){bflo(sg.x), bfhi(sg.x), bflo(sg.y), bfhi(sg.y)};
                v2u pw; pw.x = pk2(y[0], y[1]); pw.y = pk2(y[2], y[3]);
                *(v2u*)(gol + ((size_t)(n - 1) * 64 + 16 * it) * 1024) = pw; }
        }
        if (n < 32) {
            f32x4 o[4]; bf16x8 bst[2], bv[2];
#pragma unroll
            for (int ks = 0; ks < 2; ++ks) { bst[ks] = *(const LAS bf16x8*)(St + (16 * w + fr) * S72 + 32 * ks + 8 * fq); bv[ks] = tr_frag(bufc + ROFF_V, S144 * 2, w, ks, fq, fr); }
#pragma unroll
            for (int it = 0; it < 4; ++it) { o[it] = (f32x4){0.f, 0.f, 0.f, 0.f};
#pragma unroll
                for (int ks = 0; ks < 2; ++ks) { const bf16x8 qf = *(const LAS bf16x8*)(Qs + (16 * it + fr) * S72 + 32 * ks + 8 * fq); o[it] = mfma16(bst[ks], qf, o[it]); }
                o[it] = o[it] * dqv[it];
#pragma unroll
                for (int ks = 0; ks < 2; ++ks) { const bf16x8 sf = *(const LAS bf16x8*)(Ss + (16 * it + fr) * S72 + 32 * ks + 8 * fq); o[it] = mfma16(bv[ks], sf, o[it]); }
            }
#pragma unroll
            for (int dt = 0; dt < 4; ++dt) { st[dt] = st[dt] * dch;
#pragma unroll
                for (int ks = 0; ks < 2; ++ks) { const bf16x8 kf = tr_frag(bufc + ROFF_K2, S72 * 2, dt, ks, fq, fr); st[dt] = mfma16(kf, bv[ks], st[dt]); }
                v2u pw; pw.x = pk2(st[dt][0], st[dt][1]); pw.y = pk2(st[dt][2], st[dt][3]);
                *(LAS v2u*)(St + (16 * w + fr) * S72 + 16 * dt + 4 * fq) = pw; }
#pragma unroll
            for (int it = 0; it < 4; ++it) { const f32x4 v = o[it]; typedef float f32x2 __attribute__((ext_vector_type(2)));
                *(LAS f32x2*)(part + ((16 * it + fr) * 32 + w * 4 + fq) * 2) = (f32x2){(v[0] + v[1]) + (v[2] + v[3]), (v[0] * v[0] + v[1] * v[1]) + (v[2] * v[2] + v[3] * v[3])};
                op[it] = v; }
        }
    }
    LBAR();
}

constexpr int POOL_US = 0, POOL_PS = 21504, POOL_YS = POOL_PS + 64 * S136 * 2;
#define POOL_LOAD(tile_) do { _Pragma("unroll") for (int k_ = 0; k_ < 3; ++k_) { const int idx_ = tid + 512 * k_, r_ = idx_ >> 4; \
        const bool ok_ = (idx_ < 79 * 16) && ((((tile_) & 31) != 0) || r_ >= 15); const long grow_ = (long)(tile_) * 64 - 15 + r_; \
        pf[k_] = ok_ ? *(const v4u*)(P.U + (size_t)grow_ * 512 + g * 128 + vseg * 8) : (v4u){0u, 0u, 0u, 0u}; } } while (0)
template <int WIN>
__device__ __forceinline__ void pool_block_t(LAS unsigned char* lds, const Ptrs& P, int g, int tile0, int tstep, int tid) {
    const int lane = tid & 63, w = __builtin_amdgcn_readfirstlane(tid >> 6), fr = lane & 15, fq = lane >> 4;
    LAS bf16* Us = (LAS bf16*)(lds + POOL_US); LAS bf16* Ps = (LAS bf16*)(lds + POOL_PS); LAS bf16* Ys = (LAS bf16*)(lds + POOL_YS);
    bf16x8 bw[4];
#pragma unroll
    for (int ks = 0; ks < 4; ++ks) bw[ks] = *(const bf16x8*)(P.WP + (size_t)(g * 128 + 16 * w + fr) * 128 + 32 * ks + 8 * fq);
    const int vrow0 = tid >> 4, vseg = tid & 15;
    v4u pf[3];
    POOL_LOAD(tile0);
    for (int tile = tile0; tile < M / 64; tile += tstep) {
#pragma unroll
        for (int k = 0; k < 3; ++k) { const int idx = tid + 512 * k; if (idx < 79 * 16) *(LAS v4u*)(Us + (idx >> 4) * S136 + vseg * 8) = pf[k]; }
        LBAR();
        if (tile + tstep < M / 64) POOL_LOAD(tile + tstep);
#pragma unroll
        for (int rep = 0; rep < 2; ++rep) {
            const int row = vrow0 + 32 * rep; const int pos = (tile * 64 + row) & 2047; const int cnt = (pos + 1 < WIN) ? pos + 1 : WIN;
            const v4u cur = *(const LAS v4u*)(Us + (row + 15) * S136 + vseg * 8); float a[8];
#pragma unroll
            for (int k = 0; k < 4; ++k) { a[2 * k] = bflo(cur[k]); a[2 * k + 1] = bfhi(cur[k]); }
#pragma unroll
            for (int tau = 1; tau < WIN; ++tau) { const v4u v = *(const LAS v4u*)(Us + (row + 15 - tau) * S136 + vseg * 8);
#pragma unroll
                for (int k = 0; k < 4; ++k) { a[2 * k] += bflo(v[k]); a[2 * k + 1] += bfhi(v[k]); } }
            const float inv = __builtin_amdgcn_rcpf((float)cnt); v4u o;
#pragma unroll
            for (int k = 0; k < 4; ++k) o[k] = pk2(a[2 * k] * inv - bflo(cur[k]), a[2 * k + 1] * inv - bfhi(cur[k]));
            *(LAS v4u*)(Ps + row * S136 + vseg * 8) = o;
        }
        LBAR();
#pragma unroll
        for (int it = 0; it < 4; ++it) { f32x4 acc = (f32x4){0.f, 0.f, 0.f, 0.f};
#pragma unroll
            for (int ks = 0; ks < 4; ++ks) { const bf16x8 a = *(const LAS bf16x8*)(Ps + (16 * it + fr) * S136 + 32 * ks + 8 * fq); acc = mfma16(bw[ks], a, acc); }
            v2u pw; pw.x = pk2(acc[0], acc[1]); pw.y = pk2(acc[2], acc[3]);
            *(LAS v2u*)(Ys + (16 * it + fr) * S136 + 16 * w + 4 * fq) = pw; }
        LBAR();
#pragma unroll
        for (int rep = 0; rep < 2; ++rep) { const int row = vrow0 + 32 * rep; const size_t t = (size_t)tile * 64 + row;
            *(v4u*)(P.RS + t * 1024 + 512 + g * 128 + vseg * 8) = *(const LAS v4u*)(Ys + row * S136 + vseg * 8); }
    }
    LBAR();
}
__device__ __forceinline__ void pool_block(LAS unsigned char* lds, const Ptrs& P, int pblk, int npblk, int tid) {
    const int g = pblk & 3, tile0 = pblk >> 2, tstep = npblk >> 2;
    if (g == 0) pool_block_t<2>(lds, P, g, tile0, tstep, tid);
    else if (g == 1) pool_block_t<4>(lds, P, g, tile0, tstep, tid);
    else if (g == 2) pool_block_t<8>(lds, P, g, tile0, tstep, tid);
    else pool_block_t<16>(lds, P, g, tile0, tstep, tid);
}
}

struct Args { const float* in[16]; float* out; unsigned char* ws; int ph_lo, ph_hi; };
__global__ void __launch_bounds__(NTHREADS, 2) mk_fwd(Args args) {
    extern __shared__ __attribute__((aligned(16))) unsigned char lds_raw[];
    LAS unsigned char* lds = (LAS unsigned char*)lds_raw;
    const int tid = threadIdx.x, lane = tid & 63, wave = __builtin_amdgcn_readfirstlane(tid >> 6);
    const int G = gridDim.x;
    unsigned char* ws = args.ws;
    Ptrs P;
    P.x = args.in[0]; P.n1 = args.in[1]; P.g1 = args.in[2]; P.u1 = args.in[3]; P.d1 = args.in[4]; P.nm = args.in[5]; P.win = args.in[6]; P.gng = args.in[7];
    P.pw = args.in[8]; P.ps = args.in[9]; P.wout = args.in[10]; P.n2 = args.in[11]; P.g2 = args.in[12]; P.u2 = args.in[13]; P.d2 = args.in[14]; P.nf = args.in[15];
    P.out = args.out;
    P.XB = (bf16*)(ws + WS_XB); P.ACT = (bf16*)(ws + WS_BIG); P.Q = (bf16*)(ws + WS_Q); P.K = (bf16*)(ws + WS_K); P.V = (bf16*)(ws + WS_V); P.SG = (bf16*)(ws + WS_SG);
    P.U = (bf16*)(ws + WS_U); P.RS = (bf16*)(ws + WS_RS);
    P.WGU1 = (bf16*)(ws + WS_WGU1); P.WD1 = (bf16*)(ws + WS_WD1); P.WGU2 = (bf16*)(ws + WS_WGU2); P.WD2 = (bf16*)(ws + WS_WD2); P.WIN = (bf16*)(ws + WS_WIN);
    P.WOUT = (bf16*)(ws + WS_WOUT); P.WP = (bf16*)(ws + WS_WP);
    P.SSQ = (float*)(ws + WS_SSQ); P.ROPEC = (float*)(ws + WS_ROPEC); P.ROPES = (float*)(ws + WS_ROPES);
    const int lo = args.ph_lo, hi = args.ph_hi;
    if (tid < 16) ((LAS unsigned*)(lds + LDS_BARST))[tid] = 0u;
    __syncthreads();
    XcdBarrier xbar; xbar.bar = (unsigned*)(ws + WS_CTL); xbar.x = 0; xbar.st = nullptr;
    if (hi - lo > 1) xbar = xcd_barrier_post((unsigned*)(ws + WS_CTL), (volatile LAS unsigned*)(lds + LDS_BARST));
#define IN(k) (lo <= (k) && (k) < hi)
#define SEAM(k) do { if (IN(k) && IN((k) + 1)) { xcd_barrier(xbar); } } while (0)

    if (lo < 0) cg::this_grid().sync();
    if (IN(0)) { REP(0) p0_prologue(P, lds, tid, lane, wave); SEAM(0); }
    if (IN(1)) {
        pg8::Gemm g{P.XB, P.WGU1, M, NGU, D}; pg8::StaticOrder S; S.init(M, NGU, G, (int)blockIdx.x);
        pg8::EpiSwiGLU E{P.ACT, P.SSQ};
        REP(1) pg8::gemm_phase<pg8::EpiSwiGLU, pg8::StaticOrder, true, true>(lds, g, S, E);
        SEAM(1);
    }
    if (IN(2)) {
        pg8::Gemm g{P.ACT, P.WD1, M, D, FF}; pg8::StaticOrder S; S.init(M, D, G, (int)blockIdx.x);
        pg8::EpiResid E{P.XB, P.XB, P.SSQ, 0.5f};
        REP(2) pg8::gemm_phase<pg8::EpiResid, pg8::StaticOrder, true, true, true>(lds, g, S, E);
        SEAM(2);
    }
    if (IN(3)) {
        pg8::Gemm g{P.XB, P.WIN, M, INW, D}; pg8::StaticOrder S; S.init(M, INW, G, (int)blockIdx.x);
        pg8::EpiWin E{P.Q, P.V, P.SSQ, P.ROPEC, P.ROPES};
        REP(3) pg8::gemm_phase<pg8::EpiWin, pg8::StaticOrder, true, true>(lds, g, S, E);
        SEAM(3);
    }
    if (IN(4)) {
        const int bx = blockIdx.x;
        REP(4)
        if (G >= 8) {
            const int npool = (G / 2) & ~3, nret = G - npool;
            if (bx < nret) {
#if MK_NO_RET
                for (size_t i = (size_t)bx * NTHREADS + tid; i < (size_t)M * 64; i += (size_t)nret * NTHREADS) *(v4u*)(P.RS + (i >> 6) * 1024 + (i & 63) * 8) = (v4u){0u, 0u, 0u, 0u};
#else
                for (int u = bx; u < BATCH * 4; u += nret) mix::retention_unit(lds, P, u >> 2, u & 3, tid);
#endif
            } else {
#if MK_NO_POOL
                for (size_t i = (size_t)(bx - nret) * NTHREADS + tid; i < (size_t)M * 64; i += (size_t)npool * NTHREADS) *(v4u*)(P.RS + (i >> 6) * 1024 + 512 + (i & 63) * 8) = (v4u){0u, 0u, 0u, 0u};
#else
                mix::pool_block(lds, P, bx - nret, npool, tid);
#endif
                late_weights(P, lds, bx - nret, npool, lane, wave);
            }
        } else {
            for (int u = bx; u < BATCH * 4; u += G) mix::retention_unit(lds, P, u >> 2, u & 3, tid);
            for (int pb = bx; pb < 4 * G; pb += G) mix::pool_block(lds, P, pb, 4 * G, tid);
            late_weights(P, lds, bx, G, lane, wave);
        }
        SEAM(4);
    }
    if (IN(5)) {
        pg8::Gemm g{P.RS, P.WOUT, M, D, D}; pg8::StaticOrder S; S.init(M, D, G, (int)blockIdx.x);
        pg8::EpiResid E{P.XB, P.XB, P.SSQ, 1.0f};
        pg8::gemm_phase<pg8::EpiResid, pg8::StaticOrder, true, true>(lds, g, S, E);
        SEAM(5);
    }
    if (IN(6)) {
        pg8::Gemm g{P.XB, P.WGU2, M, NGU, D}; pg8::StaticOrder S; S.init(M, NGU, G, (int)blockIdx.x);
        pg8::EpiSwiGLU E{P.ACT, P.SSQ};
        REP(6) pg8::gemm_phase<pg8::EpiSwiGLU, pg8::StaticOrder, true, true>(lds, g, S, E);
        SEAM(6);
    }
    if (IN(7)) {
        pg8::Gemm g{P.ACT, P.WD2, M, D, FF}; pg8::StaticOrder S; S.init(M, D, G, (int)blockIdx.x);
        pg8::EpiFinalNorm E{P.XB, P.out, P.nf, (unsigned*)(ws + WS_XBUF), (unsigned*)(ws + WS_CTL + CTL_CNT), lds + pg8::STAGE_BYTES, 0.5f};
        pg8::gemm_phase<pg8::EpiFinalNorm, pg8::StaticOrder, true, true, true>(lds, g, S, E);
    }
#undef IN
#undef SEAM
}

extern "C" void kernel_launch(void* const* d_in, const int* in_sizes, int n_in, void* d_out, int out_size, void* d_ws, size_t ws_size, hipStream_t stream) {
    static int grid = 0;
    if (grid == 0) {
        if (n_in != 16 || in_sizes[0] != M * D || out_size != M * D || ws_size < WS_END) { fprintf(stderr, "kernel_launch: unexpected shapes (n_in %d, in0 %d, out %d, ws %zu); nothing launched\n", n_in, n_in > 0 ? in_sizes[0] : -1, out_size, ws_size); grid = -1; return; }
        int dev = 0, cus = 0, per_cu = 0;
        if (hipGetDevice(&dev) != hipSuccess || hipDeviceGetAttribute(&cus, hipDeviceAttributeMultiprocessorCount, dev) != hipSuccess) { grid = -1; return; }
        if (hipFuncSetAttribute((const void*)mk_fwd, hipFuncAttributeMaxDynamicSharedMemorySize, LDS_BYTES) != hipSuccess) { fprintf(stderr, "kernel_launch: hipFuncSetAttribute failed\n"); grid = -1; return; }
        if (hipOccupancyMaxActiveBlocksPerMultiprocessor(&per_cu, (const void*)mk_fwd, NTHREADS, LDS_BYTES) != hipSuccess || per_cu < 1) { fprintf(stderr, "kernel_launch: occupancy query gave %d\n", per_cu); per_cu = 1; }
        (void)hipGetLastError();
        grid = cus * per_cu;
        if (grid > 256) grid = 256;
        if (grid != 256) fprintf(stderr, "kernel_launch: note: %d co-resident workgroups (expected 256): the fused final-norm exchange assumes 256\n", grid);
    }
    if (grid < 0) return;
    Args a{};
    for (int i = 0; i < 16; ++i) a.in[i] = (const float*)d_in[i];
    a.out = (float*)d_out; a.ws = (unsigned char*)d_ws;
#if MK_N_LAUNCHES == 1
    if (hipMemsetAsync((char*)d_ws + WS_CTL, 0, CTL_BYTES, stream) != hipSuccess) { fprintf(stderr, "kernel_launch: hipMemsetAsync failed\n"); return; }
    a.ph_lo = 0; a.ph_hi = NPHASE;
    void* kargs[] = {&a};
    const hipError_t le = hipLaunchCooperativeKernel((const void*)mk_fwd, dim3(grid), dim3(NTHREADS), kargs, LDS_BYTES, stream);
    if (le != hipSuccess) fprintf(stderr, "kernel_launch: cooperative launch failed: %s (grid %d)\n", hipGetErrorString(le), grid);
#else
    for (int ph = 0; ph < NPHASE; ++ph) {
        if (MK_SKIP_MASK & (1 << ph)) continue;
        a.ph_lo = ph; a.ph_hi = ph + 1;
        hipLaunchKernelGGL(mk_fwd, dim3(grid), dim3(NTHREADS), LDS_BYTES, stream, a);
    }
#endif
}
```
